# Optimizing an MI355X kernel written in HIP

```python
import math
import jax, jax.numpy as jnp
from jax import lax
import numpy as np

D_MODEL = 1024
BATCH = 32
SEQ = 2048
DEPTH = 4

CTX_LEN = 256
GRID_W = 64
HEAD_DIM = 64
N_Q_HEADS = 8
N_KV_HEADS = 2
Q_PER_KV = N_Q_HEADS // N_KV_HEADS
ATTN_WIDTH = N_Q_HEADS * HEAD_DIM
KV_WIDTH = N_KV_HEADS * HEAD_DIM
WINDOW = 128
Q_BLOCK = 128
ROPE_BASE = 10000.0
ROPE_PAIRS_PER_AXIS = HEAD_DIM // 4
CONV_WIDTH = 256
CONV_K = 3
SSM_WIDTH = 256
SSM_GROUP = 16
SSM_GROUPS = SSM_WIDTH // SSM_GROUP
SSM_STATE = 64
MIX_WIDTH = ATTN_WIDTH + CONV_WIDTH + SSM_WIDTH
IN_WIDTH = ATTN_WIDTH + 2 * KV_WIDTH + 3 * CONV_WIDTH + SSM_WIDTH
D_FF = 4 * D_MODEL
N_MOD = 6
EPS = 1e-6
NEG_INF = -1e30

kernel_name = 'hybrid_dit_parallel_groups'


def rms_norm(t, g):
    tf = t.astype(jnp.float32)
    y = tf * lax.rsqrt(jnp.mean(tf * tf, axis=-1, keepdims=True) + EPS)
    return y.astype(t.dtype) * g


def modulate(t, shift, scale):
    return t * (1 + scale) + shift


def split_in_proj(p):
    sizes = [ATTN_WIDTH, KV_WIDTH, KV_WIDTH, CONV_WIDTH, CONV_WIDTH, CONV_WIDTH]
    return jnp.split(p, list(np.cumsum(sizes)), axis=-1)


def axial_rope_tables(n_tokens):
    rows = n_tokens // GRID_W
    row = jnp.broadcast_to(jnp.arange(rows)[:, None], (rows, GRID_W)).reshape(-1)
    col = jnp.broadcast_to(jnp.arange(GRID_W)[None, :], (rows, GRID_W)).reshape(-1)
    freqs = ROPE_BASE ** (-jnp.arange(ROPE_PAIRS_PER_AXIS, dtype=jnp.float32) / ROPE_PAIRS_PER_AXIS)
    ang = jnp.concatenate([row[:, None].astype(jnp.float32) * freqs,
                           col[:, None].astype(jnp.float32) * freqs], axis=-1)
    return jnp.cos(ang), jnp.sin(ang)


def _rotate(t, c, s):
    t1, t2 = jnp.split(t, 2, axis=-1)
    return jnp.concatenate([t1 * c - t2 * s, t1 * s + t2 * c], axis=-1)


def apply_axial_rope(t, cos, sin):
    c = cos[:, None, :].astype(t.dtype)
    s = sin[:, None, :].astype(t.dtype)
    n = ROPE_PAIRS_PER_AXIS
    half = HEAD_DIM // 2
    return jnp.concatenate([_rotate(t[..., :half], c[..., :n], s[..., :n]),
                            _rotate(t[..., half:], c[..., n:], s[..., n:])], axis=-1)


def windowed_latent_attention(q, k, v, kc, vc, sink):
    bsz, n_lat = q.shape[0], q.shape[1]
    n_ctx = kc.shape[1]
    n_blocks = n_lat // Q_BLOCK
    span = Q_BLOCK + 2 * WINDOW
    scale = HEAD_DIM ** -0.5
    pad = ((0, 0), (WINDOW, WINDOW), (0, 0), (0, 0))
    kp = jnp.pad(k, pad)
    vp = jnp.pad(v, pad)
    s_ctx_all = None

    def block(i):
        start = i * Q_BLOCK
        qb = lax.dynamic_slice_in_dim(q, start, Q_BLOCK, axis=1)
        kb = lax.dynamic_slice_in_dim(kp, start, span, axis=1)
        vb = lax.dynamic_slice_in_dim(vp, start, span, axis=1)
        qpos = start + jnp.arange(Q_BLOCK)
        kpos = start - WINDOW + jnp.arange(span)
        mask = (jnp.abs(qpos[:, None] - kpos[None, :]) <= WINDOW) & (kpos >= 0) & (kpos < n_lat)
        s_lat = jnp.einsum('bqhgd,bkhd->bhgqk', qb, kb).astype(jnp.float32) * scale
        s_lat = jnp.where(mask, s_lat, NEG_INF)
        s_ctx = jnp.einsum('bqhgd,bkhd->bhgqk', qb, kc).astype(jnp.float32) * scale
        s_sink = jnp.broadcast_to(sink.astype(jnp.float32)[None, :, :, None, None],
                                  s_ctx.shape[:-1] + (1,))
        p = jax.nn.softmax(jnp.concatenate([s_lat, s_ctx, s_sink], axis=-1), axis=-1)
        p_lat = p[..., :span].astype(v.dtype)
        p_ctx = p[..., span:span + n_ctx].astype(v.dtype)
        return (jnp.einsum('bhgqk,bkhd->bqhgd', p_lat, vb)
                + jnp.einsum('bhgqk,bkhd->bqhgd', p_ctx, vc))

    o = lax.map(block, jnp.arange(n_blocks))
    return jnp.moveaxis(o, 0, 1).reshape(bsz, n_lat, ATTN_WIDTH)


def context_attention(qc, kc, vc, sink):
    bsz, n_ctx = qc.shape[0], qc.shape[1]
    s = jnp.einsum('bqhgd,bkhd->bhgqk', qc, kc).astype(jnp.float32) * (HEAD_DIM ** -0.5)
    s_sink = jnp.broadcast_to(sink.astype(jnp.float32)[None, :, :, None, None], s.shape[:-1] + (1,))
    p = jax.nn.softmax(jnp.concatenate([s, s_sink], axis=-1), axis=-1)[..., :n_ctx]
    o = jnp.einsum('bhgqk,bkhd->bqhgd', p.astype(vc.dtype), vc)
    return o.reshape(bsz, n_ctx, ATTN_WIDTH)


def centred_conv3(z, w):
    zp = jnp.pad(z, ((0, 0), (1, 1), (0, 0)))
    return zp[:, :-2] * w[0] + zp[:, 1:-1] * w[1] + zp[:, 2:] * w[2]


def diag_scan(lam_bar, drive, h0, reverse):
    if h0 is not None:
        edge = -1 if reverse else 0
        drive = drive.at[:, edge].add(lam_bar * h0)
    decay = jnp.broadcast_to(lam_bar, (1, drive.shape[1]) + lam_bar.shape)

    def combine(left, right):
        a_l, b_l = left
        a_r, b_r = right
        return a_l * a_r, a_r * b_l + b_r

    _, h = lax.associative_scan(combine, (decay, drive), reverse=reverse, axis=1)
    return h


def s5_bidirectional(u, uc, lam_re, lam_im, log_dt, b_re, b_im, c_re, c_im, d_skip, w_glu, b_glu,
                     with_ctx_out):
    f32 = jnp.float32
    lam = lax.complex(lam_re.astype(f32), lam_im.astype(f32))
    dt = jnp.exp(log_dt.astype(f32))[..., None]
    lam_bar = jnp.exp(lam * dt)
    b_bar = ((lam_bar - 1) / lam)[..., None] * lax.complex(b_re.astype(f32), b_im.astype(f32))
    c_mat = lax.complex(c_re.astype(f32), c_im.astype(f32))

    def drive(t, direction):
        tg = t.astype(f32).reshape(t.shape[0], t.shape[1], SSM_GROUPS, SSM_GROUP).astype(jnp.complex64)
        return jnp.einsum('blgi,gpi->blgp', tg, b_bar[direction])

    h_ctx_f = diag_scan(lam_bar[0], drive(uc, 0), None, False)
    h_ctx_b = diag_scan(lam_bar[1], drive(uc, 1), None, True)
    h_lat_f = diag_scan(lam_bar[0], drive(u, 0), h_ctx_f[:, -1], False)
    h_lat_b = diag_scan(lam_bar[1], drive(u, 1), h_ctx_b[:, 0], True)

    def readout(t, hf, hb):
        y = jnp.real(jnp.einsum('blgp,gip->blgi', hf, c_mat[0])
                     + jnp.einsum('blgp,gip->blgi', hb, c_mat[1])).reshape(t.shape)
        y = (y + d_skip.astype(f32) * t.astype(f32)).astype(t.dtype)
        g = jax.nn.gelu(y)
        return g * jax.nn.sigmoid(g @ w_glu + b_glu)

    out_ctx = readout(uc, h_ctx_f, h_ctx_b) if with_ctx_out else None
    return readout(u, h_lat_f, h_lat_b), out_ctx


def hybrid_mixer(h_lat, h_ctx, w_in, conv_w, sink, lam_re, lam_im, log_dt, b_re, b_im, c_re, c_im,
                 d_skip, w_glu, b_glu, w_out, cos, sin, with_ctx_out):
    bsz, n_lat, _ = h_lat.shape
    n_ctx = h_ctx.shape[1]
    q, k, v, cb, cc, cx, u = split_in_proj(h_lat @ w_in)
    qc, kc, vc, cbc, ccc, cxc, uc = split_in_proj(h_ctx @ w_in)
    sink = sink.reshape(N_KV_HEADS, Q_PER_KV)
    q = apply_axial_rope(q.reshape(bsz, n_lat, N_Q_HEADS, HEAD_DIM), cos, sin)
    q = q.reshape(bsz, n_lat, N_KV_HEADS, Q_PER_KV, HEAD_DIM)
    k = apply_axial_rope(k.reshape(bsz, n_lat, N_KV_HEADS, HEAD_DIM), cos, sin)
    v = v.reshape(bsz, n_lat, N_KV_HEADS, HEAD_DIM)
    kc = kc.reshape(bsz, n_ctx, N_KV_HEADS, HEAD_DIM)
    vc = vc.reshape(bsz, n_ctx, N_KV_HEADS, HEAD_DIM)
    attn = windowed_latent_attention(q, k, v, kc, vc, sink)
    conv = cb * centred_conv3(cc * cx, conv_w)
    ssm, ssm_c = s5_bidirectional(u, uc, lam_re, lam_im, log_dt, b_re, b_im, c_re, c_im, d_skip,
                                  w_glu, b_glu, with_ctx_out)
    out_lat = jnp.concatenate([attn, conv, ssm], axis=-1) @ w_out
    if not with_ctx_out:
        return out_lat, None
    qc = qc.reshape(bsz, n_ctx, N_KV_HEADS, Q_PER_KV, HEAD_DIM)
    attn_c = context_attention(qc, kc, vc, sink)
    conv_c = cbc * centred_conv3(ccc * cxc, conv_w)
    out_ctx = jnp.concatenate([attn_c, conv_c, ssm_c], axis=-1) @ w_out
    return out_lat, out_ctx


def squared_relu_mlp(t, w1, w2):
    return jnp.square(jax.nn.relu(t @ w1)) @ w2


def setup_inputs(seed: int = 0) -> dict:
    key = jax.random.key(seed)
    ks = jax.random.split(key, 24)
    f32 = jnp.float32
    nrm = lambda k, shape, s: jax.random.normal(k, shape, f32) * s
    lam_im_base = jnp.pi * jnp.arange(SSM_STATE, dtype=f32)
    return {
        'x': nrm(ks[0], (BATCH, SEQ, D_MODEL), 1.0),
        'c': nrm(ks[1], (BATCH, D_MODEL), 1.0),
        'ctx': nrm(ks[2], (BATCH, CTX_LEN, D_MODEL), 1.0),
        'c_ctx': nrm(ks[3], (D_MODEL,), 1.0),
        'w_ada': nrm(ks[4], (DEPTH, D_MODEL, N_MOD * D_MODEL), 0.5 * D_MODEL ** -0.5),
        'b_ada': nrm(ks[5], (DEPTH, N_MOD * D_MODEL), 0.02),
        'norm_g': 1.0 + nrm(ks[6], (DEPTH, 4, D_MODEL), 0.02),
        'w_in': nrm(ks[7], (DEPTH, D_MODEL, IN_WIDTH), D_MODEL ** -0.5),
        'conv_w': nrm(ks[8], (DEPTH, CONV_K, CONV_WIDTH), CONV_K ** -0.5),
        'attn_sink': nrm(ks[9], (DEPTH, N_Q_HEADS), 0.5),
        'ssm_lam_re': -0.5 + nrm(ks[10], (DEPTH, 2, SSM_GROUPS, SSM_STATE), 0.01),
        'ssm_lam_im': lam_im_base + nrm(ks[11], (DEPTH, 2, SSM_GROUPS, SSM_STATE), 0.01),
        'ssm_log_dt': jax.random.uniform(ks[12], (DEPTH, 2, SSM_GROUPS), f32,
                                         minval=math.log(1e-3), maxval=math.log(1e-1)),
        'ssm_b_re': nrm(ks[13], (DEPTH, 2, SSM_GROUPS, SSM_STATE, SSM_GROUP), (2 * SSM_GROUP) ** -0.5),
        'ssm_b_im': nrm(ks[14], (DEPTH, 2, SSM_GROUPS, SSM_STATE, SSM_GROUP), (2 * SSM_GROUP) ** -0.5),
        'ssm_c_re': nrm(ks[15], (DEPTH, 2, SSM_GROUPS, SSM_GROUP, SSM_STATE), (2 * SSM_STATE) ** -0.5),
        'ssm_c_im': nrm(ks[16], (DEPTH, 2, SSM_GROUPS, SSM_GROUP, SSM_STATE), (2 * SSM_STATE) ** -0.5),
        'ssm_d': nrm(ks[17], (DEPTH, SSM_WIDTH), 1.0),
        'w_glu': nrm(ks[18], (DEPTH, SSM_WIDTH, SSM_WIDTH), SSM_WIDTH ** -0.5),
        'b_glu': nrm(ks[19], (DEPTH, SSM_WIDTH), 0.02),
        'w_out': nrm(ks[20], (DEPTH, MIX_WIDTH, D_MODEL), MIX_WIDTH ** -0.5),
        'w_mlp_in': nrm(ks[21], (DEPTH, D_MODEL, D_FF), D_MODEL ** -0.5),
        'w_mlp_out': nrm(ks[22], (DEPTH, D_FF, D_MODEL), D_FF ** -0.5),
    }


def reference(x, c, ctx, c_ctx, w_ada, b_ada, norm_g, w_in, conv_w, attn_sink, ssm_lam_re, ssm_lam_im,
              ssm_log_dt, ssm_b_re, ssm_b_im, ssm_c_re, ssm_c_im, ssm_d, w_glu, b_glu, w_out,
              w_mlp_in, w_mlp_out):
    cos, sin = axial_rope_tables(x.shape[1])
    c_act = jax.nn.silu(c)
    c_ctx_act = jax.nn.silu(c_ctx)
    h, hc = x, ctx
    for l in range(DEPTH):
        with_ctx_out = l < DEPTH - 1
        mod = (c_act @ w_ada[l] + b_ada[l])[:, None, :]
        mod_c = c_ctx_act @ w_ada[l] + b_ada[l]
        sh1, sc1, g1, sh2, sc2, g2 = jnp.split(mod, N_MOD, axis=-1)
        sh1c, sc1c, g1c, sh2c, sc2c, g2c = jnp.split(mod_c, N_MOD, axis=-1)
        g_pre_mix, g_post_mix, g_pre_mlp, g_post_mlp = norm_g[l]
        a_lat = modulate(rms_norm(h, g_pre_mix), sh1, sc1)
        a_ctx = modulate(rms_norm(hc, g_pre_mix), sh1c, sc1c)
        m_lat, m_ctx = hybrid_mixer(a_lat, a_ctx, w_in[l], conv_w[l], attn_sink[l], ssm_lam_re[l],
                                    ssm_lam_im[l], ssm_log_dt[l], ssm_b_re[l], ssm_b_im[l], ssm_c_re[l],
                                    ssm_c_im[l], ssm_d[l], w_glu[l], b_glu[l], w_out[l], cos, sin,
                                    with_ctx_out)
        h = h + g1 * rms_norm(m_lat, g_post_mix)
        f_lat = squared_relu_mlp(modulate(rms_norm(h, g_pre_mlp), sh2, sc2), w_mlp_in[l], w_mlp_out[l])
        h = h + g2 * rms_norm(f_lat, g_post_mlp)
        if with_ctx_out:
            hc = hc + g1c * rms_norm(m_ctx, g_post_mix)
            f_ctx = squared_relu_mlp(modulate(rms_norm(hc, g_pre_mlp), sh2c, sc2c), w_mlp_in[l], w_mlp_out[l])
            hc = hc + g2c * rms_norm(f_ctx, g_post_mlp)
    return h
```

```cpp
#include <hip/hip_runtime.h>
#include <hip/hip_cooperative_groups.h>
#include <cstdio>
#include <cstdint>
namespace cg = cooperative_groups;

#define LAS __attribute__((address_space(3)))
typedef unsigned short bf16_t;
typedef short bf16x8 __attribute__((ext_vector_type(8)));
typedef float f32x4 __attribute__((ext_vector_type(4)));
typedef float f32x2 __attribute__((ext_vector_type(2)));
typedef float f32x16 __attribute__((ext_vector_type(16)));
typedef unsigned u32x4 __attribute__((ext_vector_type(4)));
typedef unsigned u32x2 __attribute__((ext_vector_type(2)));

constexpr int DM = 1024, SEQ = 2048, NB = 32, CTXL = 256, DEPTH = 4;
constexpr int TLAT = NB * SEQ, TCTX = NB * CTXL, TALL = TLAT + TCTX;
constexpr int INW = 1792, DFF = 4096;
constexpr int LDS_BYTES = 139264;
#ifndef REP_GEMM
#define REP_GEMM 1
#endif
#ifndef REP_MIX
#define REP_MIX 1
#endif

constexpr size_t OFF_MOD  = 0;
constexpr size_t OFF_ROPE = OFF_MOD + (size_t)4 * 33 * 6144 * 4;
constexpr size_t OFF_LAMB = OFF_ROPE + 8192;
constexpr size_t OFF_BFR  = OFF_LAMB + 131072;
constexpr size_t OFF_CFR  = OFF_BFR + 1048576;
constexpr size_t OFF_E    = OFF_CFR + 524288;
constexpr size_t OFF_WIN  = OFF_E + 18874368;
constexpr size_t OFF_WOUT = OFF_WIN + 14680064;
constexpr size_t OFF_W1   = OFF_WOUT + 8388608;
constexpr size_t OFF_W2   = OFF_W1 + 33554432;
constexpr size_t OFF_WGLU = OFF_W2 + 33554432;
constexpr size_t OFF_HC   = OFF_WGLU + 524288;
constexpr size_t OFF_A    = OFF_HC + 33554432;
constexpr size_t OFF_MB   = OFF_A + 150994944;
constexpr size_t OFF_Z    = OFF_MB + 150994944;
constexpr size_t OFF_P    = OFF_Z;
constexpr size_t OFF_MIX  = OFF_Z + 264241152;
constexpr size_t OFF_E2   = OFF_Z + 603979776;
constexpr size_t OFF_BAR  = OFF_E2 + 18874368;
constexpr size_t WS_END   = OFF_BAR + 16384;

struct Args { const float* in[23]; float* out; unsigned char* ws; int ph_lo, ph_hi; };

__device__ __forceinline__ unsigned cvt_pk_bf16(float lo, float hi) { unsigned r; asm("v_cvt_pk_bf16_f32 %0, %1, %2" : "=v"(r) : "v"(lo), "v"(hi)); return r; }
__device__ __forceinline__ float bf_lo(unsigned u) { return __uint_as_float(u << 16); }
__device__ __forceinline__ float bf_hi(unsigned u) { return __uint_as_float(u & 0xffff0000u); }
__device__ __forceinline__ float bf2f(bf16_t x) { return __uint_as_float(((unsigned)x) << 16); }
#define DPP_ADD(v, ctrl) ((v) + __builtin_bit_cast(float, __builtin_amdgcn_update_dpp(0, __builtin_bit_cast(int, (v)), (ctrl), 0xF, 0xF, true)))
__device__ __forceinline__ float wave_sum(float v) {
    v = DPP_ADD(v, 0xB1);
    v = DPP_ADD(v, 0x4E);
    v = DPP_ADD(v, 0x141);
    v = DPP_ADD(v, 0x140);
    const int iv = __builtin_bit_cast(int, v);
    const float s0 = __builtin_bit_cast(float, __builtin_amdgcn_readlane(iv, 0)), s1 = __builtin_bit_cast(float, __builtin_amdgcn_readlane(iv, 16));
    const float s2 = __builtin_bit_cast(float, __builtin_amdgcn_readlane(iv, 32)), s3 = __builtin_bit_cast(float, __builtin_amdgcn_readlane(iv, 48));
    return (s0 + s1) + (s2 + s3);
}
#define LDS_WAIT() asm volatile("s_waitcnt lgkmcnt(0)" ::: "memory")
__device__ __forceinline__ int fresh_tid() { int t = threadIdx.x; asm volatile("" : "+v"(t)); return t; }
#define MFMA16(a, b, c) __builtin_amdgcn_mfma_f32_16x16x32_bf16((a), (b), (c), 0, 0, 0)
#define MFMA32(a, b, c) __builtin_amdgcn_mfma_f32_32x32x16_bf16((a), (b), (c), 0, 0, 0)

namespace pg8 {
constexpr int BM = 256, BK = 64, HALF = 128, HTB = HALF * BK * 2, STAGE_BYTES = 8 * HTB, NXCD = 8, WGM = 8;
__device__ __forceinline__ int lds_byte(int r, int c) { const int st = (r >> 4) * 2 + (c >> 5), rr = r & 15, cc = c & 31, ob = rr * 64 + cc * 2; return st * 1024 + (ob ^ (((ob >> 9) & 1) << 5)); }
__device__ __forceinline__ void stage_rc(int b, int& R, int& C) { const int st = b / 1024, sb = b % 1024, swz = sb ^ (((sb >> 9) & 1) << 5); R = (st >> 1) * 16 + swz / 64; C = (st & 1) * 32 + (swz % 64) / 2; }
__device__ __forceinline__ int perm32(int rho) { const int n = rho >> 4, i = rho & 15; return 8 * (i >> 2) + 4 * n + (i & 3); }
struct Unit { int pm, pn, half, kh; };
struct Gemm { const bf16_t* A; const bf16_t* Bt; int K; };
struct Order {
    int nM, nN, nwg, G, c, extra, split;
    __device__ __forceinline__ bool next(int i, Unit& u) const {
        const int L = i * G + c;
        u.half = 0; u.kh = 0;
        if (L >= nwg + extra) return false;
        if (L >= nwg) { const int e = L - nwg;
            if (split) { const int uu = e >> 1; u.half = 1; u.kh = e & 1; u.pm = nM + uu / nN; u.pn = uu % nN; return true; }
            u.pm = nM + (e >> 1); u.pn = (e & 1) ? 6 : 2; return true; }
        int wgid = L; { const int q = nwg / NXCD, r = nwg % NXCD, xcd = wgid % NXCD, off = wgid / NXCD; wgid = (xcd < r ? xcd * (q + 1) : r * (q + 1) + (xcd - r) * q) + off; }
        const int nig = WGM * nN, gid = wgid / nig, fm = gid * WGM, gsz = (nM - fm) < WGM ? (nM - fm) : WGM;
        u.pm = fm + ((wgid % nig) % gsz); u.pn = (wgid % nig) / gsz; return true;
    }
};
template <int ACT>
struct EpiBf {
    static constexpr bool PERM = true;
    bf16_t* O; int ldc; bf16_t* O2;
    __device__ __forceinline__ void operator()(const f32x4 (&acc)[2][2][4][2], const Unit& u, int wr, int wc, int fr, int fq) const {
        const int row0 = u.pm * BM + wr * 64 + fr, col0 = u.pn * BM + wc * 32 + 8 * fq;
        bf16_t* base = u.kh ? O2 - (size_t)TLAT * ldc : O;
#pragma unroll
        for (int ai = 0; ai < 2; ++ai)
#pragma unroll
            for (int m = 0; m < 4; ++m) { bf16_t* rowp = base + (size_t)(row0 + ai * HALF + m * 16) * ldc + col0;
#pragma unroll
                for (int bj = 0; bj < 2; ++bj) { f32x4 v0 = acc[ai][bj][m][0], v1 = acc[ai][bj][m][1];
                    if (ACT == 1) { v0.x = fmaxf(v0.x, 0.f); v0.y = fmaxf(v0.y, 0.f); v0.z = fmaxf(v0.z, 0.f); v0.w = fmaxf(v0.w, 0.f); v0 = v0 * v0;
                                    v1.x = fmaxf(v1.x, 0.f); v1.y = fmaxf(v1.y, 0.f); v1.z = fmaxf(v1.z, 0.f); v1.w = fmaxf(v1.w, 0.f); v1 = v1 * v1; }
                    u32x4 w; w.x = cvt_pk_bf16(v0.x, v0.y); w.y = cvt_pk_bf16(v0.z, v0.w); w.z = cvt_pk_bf16(v1.x, v1.y); w.w = cvt_pk_bf16(v1.z, v1.w);
                    *(u32x4*)(rowp + bj * HALF) = w; } }
    }
};
struct EpiP {
    static constexpr bool PERM = true;
    bf16_t* P; const float* rc; const float* rs;
    __device__ __forceinline__ void operator()(const f32x4 (&acc)[2][2][4][2], const Unit& u, int wr, int wc, int fr, int fq) const {
        const int row0 = u.pm * BM + wr * 64 + fr, col0 = u.pn * BM + wc * 32 + 8 * fq;
        const bool lat = u.pm < 256;
        const float qs = (u.pn < 2) ? 0.125f * 1.4426950408889634f : 1.f;
        const bool rope_any = lat && (u.pn <= 2);
        const float sgn = fq < 2 ? -1.f : 1.f;
        const bool colrot = (wc & 1) != 0;
        f32x4 c0[4], c1[4], s0[4], s1[4];
#pragma unroll
        for (int k = 0; k < 4; ++k) { c0[k] = (f32x4){1.f, 1.f, 1.f, 1.f}; c1[k] = c0[k]; s0[k] = (f32x4){0.f, 0.f, 0.f, 0.f}; s1[k] = s0[k]; }
        if (rope_any) {
#pragma unroll
            for (int k = 0; k < 4; ++k) {
                if (colrot || k < 2) {
                    const int row = colrot ? row0 + k * 16 : row0 + k * HALF; const int pos = row & 2047; const int pidx = colrot ? (pos & 63) : (pos >> 6); const int o = pidx * 16 + 8 * (fq & 1);
                    c0[k] = *(const f32x4*)(rc + o); c1[k] = *(const f32x4*)(rc + o + 4); s0[k] = *(const f32x4*)(rs + o) * sgn; s1[k] = *(const f32x4*)(rs + o + 4) * sgn; } }
        }
#pragma unroll
        for (int ai = 0; ai < 2; ++ai)
#pragma unroll
            for (int m = 0; m < 4; ++m) { const int row = row0 + ai * HALF + m * 16; bf16_t* rowp = P + (size_t)row * INW + col0;
                const f32x4 cc0 = colrot ? c0[m] : c0[ai], cc1 = colrot ? c1[m] : c1[ai], ss0 = colrot ? s0[m] : s0[ai], ss1 = colrot ? s1[m] : s1[ai];
#pragma unroll
                for (int bj = 0; bj < 2; ++bj) { f32x4 v0 = acc[ai][bj][m][0], v1 = acc[ai][bj][m][1];
                    const bool rope = lat && (u.pn < 2 || (u.pn == 2 && bj == 0));
                    if (rope) { f32x4 p0, p1;
#pragma unroll
                        for (int e = 0; e < 4; ++e) { p0[e] = __shfl_xor(v0[e], 32); p1[e] = __shfl_xor(v1[e], 32); }
                        v0 = v0 * cc0 + p0 * ss0; v1 = v1 * cc1 + p1 * ss1; }
                    v0 = v0 * qs; v1 = v1 * qs;
                    u32x4 w; w.x = cvt_pk_bf16(v0.x, v0.y); w.y = cvt_pk_bf16(v0.z, v0.w); w.z = cvt_pk_bf16(v1.x, v1.y); w.w = cvt_pk_bf16(v1.z, v1.w);
                    *(u32x4*)(rowp + bj * HALF) = w; } }
    }
};

template <class Epi>
__device__ __forceinline__ void gemm_phase(LAS unsigned char* lds, const Gemm g, const Order& S, const Epi& E) {
    const int tid = fresh_tid(), wid = __builtin_amdgcn_readfirstlane(tid >> 6), lane = tid & 63, wr = wid >> 2, wc = wid & 3, fr = lane & 15, fq = lane >> 4;
    const int K = g.K, nt = K / BK;
    unsigned voffA[2], voffB[2];
#pragma unroll
    for (int i = 0; i < 2; ++i) { int R, C; stage_rc(tid * 16 + i * 8192, R, C); const int Rb = Epi::PERM ? ((R & ~31) + perm32(R & 31)) : R;
        voffA[i] = (unsigned)(R * K + C) * 2u; voffB[i] = (unsigned)(Rb * K + C) * 2u; }
    const size_t kstep = (size_t)(BK * 2);
    const size_t hstep = (size_t)HALF * K * 2;
    const size_t tstep = 2 * hstep;
    const unsigned ldsw = (unsigned)wid * 1024u;
    const int aoff = lds_byte(wr * 64 + fr, fq * 8), boff = lds_byte(wc * 32 + fr, fq * 8);
#define PG8_SA(b, h) (((b) * 2 + (h)) * HTB)
#define PG8_SB(b, h) ((4 + (b) * 2 + (h)) * HTB)
#define PG8_STAGE(bufoff, gbase, voff) do { _Pragma("unroll") for (int _i = 0; _i < 2; ++_i) \
        __builtin_amdgcn_global_load_lds((const unsigned*)((const char*)(gbase) + (voff)[_i]), (LAS unsigned*)(lds + (bufoff) + ldsw + _i * 8192), 16, 0, 0); } while (0)
#define PG8_LDA(dst, b, h) do { _Pragma("unroll") for (int m = 0; m < 4; ++m) _Pragma("unroll") for (int k = 0; k < 2; ++k) dst[m][k] = *(const LAS bf16x8*)(lds + PG8_SA(b, h) + aoff + m * 2048 + k * 1024); } while (0)
#define PG8_LDB(dst, b, h) do { _Pragma("unroll") for (int n = 0; n < 2; ++n) _Pragma("unroll") for (int k = 0; k < 2; ++k) dst[n][k] = *(const LAS bf16x8*)(lds + PG8_SB(b, h) + boff + n * 2048 + k * 1024); } while (0)
#define PG8_MMA(ai, bj, At, Bt) do { __builtin_amdgcn_s_setprio(1); _Pragma("unroll") for (int m = 0; m < 4; ++m) _Pragma("unroll") for (int n = 0; n < 2; ++n) _Pragma("unroll") for (int k = 0; k < 2; ++k) \
        acc[ai][bj][m][n] = __builtin_amdgcn_mfma_f32_16x16x32_bf16(Bt[n][k], At[m][k], acc[ai][bj][m][n], 0, 0, 0); __builtin_amdgcn_s_setprio(0); } while (0)
#define PG8_WAIT_V(n) asm volatile("s_waitcnt vmcnt(" #n ")" ::: "memory")
#define PG8_WAIT_L(n) asm volatile("s_waitcnt lgkmcnt(" #n ")" ::: "memory")
#define PG8_BAR __builtin_amdgcn_s_barrier()
#define PG8_SCHED __builtin_amdgcn_sched_barrier(0)
    Unit cur, nxt; int ui = 0;
    if (!S.next(0, cur)) return;
    f32x4 acc[2][2][4][2];
#pragma unroll
    for (int a = 0; a < 2; ++a)
#pragma unroll
        for (int b = 0; b < 2; ++b)
#pragma unroll
            for (int m = 0; m < 4; ++m)
#pragma unroll
                for (int n = 0; n < 2; ++n) acc[a][b][m][n] = (f32x4){0.f, 0.f, 0.f, 0.f};
    bf16x8 At[4][2], B0[2][2], B1[2][2];
    const size_t khoff = (size_t)K;
    const char* cA = (const char*)g.A + (size_t)cur.pm * tstep + (cur.kh ? khoff : 0); const char* cB = (const char*)g.Bt + (size_t)cur.pn * tstep + (cur.kh ? khoff : 0);
    PG8_STAGE(PG8_SB(0, 0), cB, voffB); PG8_STAGE(PG8_SB(0, 1), cB + hstep, voffB); PG8_STAGE(PG8_SA(0, 0), cA, voffA); PG8_STAGE(PG8_SA(0, 1), cA + hstep, voffA);
    if (wr == 1) PG8_BAR;
    PG8_WAIT_V(2); PG8_BAR;
    PG8_STAGE(PG8_SB(1, 0), cB + kstep, voffB); PG8_STAGE(PG8_SA(1, 0), cA + kstep, voffA); PG8_STAGE(PG8_SB(1, 1), cB + hstep + kstep, voffB);
    PG8_WAIT_V(6); PG8_BAR;
    for (;;) {
        const bool has_next = S.next(ui + 1, nxt);
        const char* nA = has_next ? (const char*)g.A + (size_t)nxt.pm * tstep + (nxt.kh ? khoff : 0) : cA; const char* nB = has_next ? (const char*)g.Bt + (size_t)nxt.pn * tstep + (nxt.kh ? khoff : 0) : cB;
        const int cnt = cur.half ? (nt >> 1) : nt;
        for (int t = 0; t < cnt; t += 2) {
            const bool last = (t == cnt - 2);
            const char* a1 = cA + (size_t)(t + 1) * kstep;
            const char* a2 = last ? nA : cA + (size_t)(t + 2) * kstep; const char* b2 = last ? nB : cB + (size_t)(t + 2) * kstep;
            const char* a3 = a2 + kstep; const char* b3 = b2 + kstep;
            PG8_LDB(B0, 0, 0); PG8_LDB(B1, 0, 1); PG8_SCHED; PG8_LDA(At, 0, 0); PG8_STAGE(PG8_SA(1, 1), a1 + hstep, voffA);
            PG8_WAIT_V(8); PG8_WAIT_L(0); PG8_BAR; PG8_MMA(0, 0, At, B0); PG8_MMA(0, 1, At, B1); PG8_BAR; PG8_SCHED;
            PG8_LDA(At, 0, 1); PG8_STAGE(PG8_SB(0, 0), b2, voffB); PG8_STAGE(PG8_SB(0, 1), b2 + hstep, voffB); PG8_STAGE(PG8_SA(0, 0), a2, voffA);
            PG8_WAIT_V(8); PG8_WAIT_L(0); PG8_BAR; PG8_MMA(1, 0, At, B0); PG8_MMA(1, 1, At, B1); PG8_BAR; PG8_SCHED;
            PG8_LDB(B0, 1, 0); PG8_LDB(B1, 1, 1); PG8_SCHED; PG8_LDA(At, 1, 0); PG8_STAGE(PG8_SA(0, 1), a2 + hstep, voffA);
            PG8_WAIT_V(8); PG8_WAIT_L(0); PG8_BAR; PG8_MMA(0, 0, At, B0); PG8_MMA(0, 1, At, B1); PG8_BAR; PG8_SCHED;
            PG8_LDA(At, 1, 1); PG8_STAGE(PG8_SB(1, 0), b3, voffB); PG8_STAGE(PG8_SB(1, 1), b3 + hstep, voffB); PG8_STAGE(PG8_SA(1, 0), a3, voffA);
            PG8_WAIT_V(8); PG8_WAIT_L(0); PG8_BAR; PG8_MMA(1, 0, At, B0); PG8_MMA(1, 1, At, B1); PG8_BAR; PG8_SCHED;
        }
        if (wr == 0) PG8_BAR;
        E(acc, cur, wr, wc, fr, fq);
        if (!has_next) break;
#pragma unroll
        for (int a = 0; a < 2; ++a)
#pragma unroll
            for (int b = 0; b < 2; ++b)
#pragma unroll
                for (int m = 0; m < 4; ++m)
#pragma unroll
                    for (int n = 0; n < 2; ++n) acc[a][b][m][n] = (f32x4){0.f, 0.f, 0.f, 0.f};
        cur = nxt; cA = nA; cB = nB; ++ui;
        if (wr == 1) PG8_BAR;
    }
    PG8_WAIT_V(0);
    PG8_BAR;
#undef PG8_SA
#undef PG8_SB
#undef PG8_STAGE
#undef PG8_LDA
#undef PG8_LDB
#undef PG8_MMA
#undef PG8_WAIT_V
#undef PG8_WAIT_L
#undef PG8_BAR
#undef PG8_SCHED
}
}

__device__ __forceinline__ void transpose_item(const float* W, int K, int N, bf16_t* WT, LAS float* scr, int item, int lane) {
    const int nblk = N / 32, kb = item / nblk, nb = item % nblk, k0 = 64 * kb, n0 = 32 * nb;
#pragma unroll 8
    for (int i = 0; i < 32; ++i) { const int kk = 2 * i + (lane >> 5); scr[kk * 33 + (lane & 31)] = __builtin_nontemporal_load(W + (size_t)(k0 + kk) * N + n0 + (lane & 31)); }
    LDS_WAIT();
    const int c = lane & 7;
#pragma unroll
    for (int j = 0; j < 4; ++j) { const int n = (lane >> 3) + 8 * j; const LAS float* s = scr + (8 * c) * 33 + n;
        u32x4 o; o.x = cvt_pk_bf16(s[0 * 33], s[1 * 33]); o.y = cvt_pk_bf16(s[2 * 33], s[3 * 33]); o.z = cvt_pk_bf16(s[4 * 33], s[5 * 33]); o.w = cvt_pk_bf16(s[6 * 33], s[7 * 33]);
        *(u32x4*)(WT + (size_t)(n0 + n) * K + k0 + 8 * c) = o; }
    LDS_WAIT();
}

__device__ __forceinline__ void ssm_tables(const Args& a, int q, int lane) {
    const float* lam_re = a.in[10]; const float* lam_im = a.in[11]; const float* log_dt = a.in[12];
    const float* b_re = a.in[13]; const float* b_im = a.in[14]; const float* c_re = a.in[15]; const float* c_im = a.in[16];
    f32x4* LAMB = (f32x4*)(a.ws + OFF_LAMB); u32x4* BFR = (u32x4*)(a.ws + OFF_BFR); u32x4* CFR = (u32x4*)(a.ws + OFF_CFR);
    const float lr = lam_re[q * 64 + lane], li = lam_im[q * 64 + lane];
    const float dt = expf(log_dt[q]);
    const float er = expf(lr * dt);
    float sn, cs; sincosf(li * dt, &sn, &cs);
    const float are = er * cs, aim = er * sn;
    float pr = are, pi = aim;
#pragma unroll
    for (int i = 0; i < 6; ++i) { const float nr = pr * pr - pi * pi, ni = 2.f * pr * pi; pr = nr; pi = ni; }
    LAMB[q * 64 + lane] = (f32x4){are, aim, pr, pi};
    const float den = lr * lr + li * li;
    const float cr = ((are - 1.f) * lr + aim * li) / den, ci = (aim * lr - (are - 1.f) * li) / den;
    const int i0 = 8 * ((lane >> 4) & 1), lo = lane >> 5;
#pragma unroll
    for (int nt = 0; nt < 8; ++nt) {
        const int n = 16 * nt + (lane & 15), pp = n & 63, part = n >> 6;
        const float crp = __shfl(cr, pp), cip = __shfl(ci, pp);
        const float* br = b_re + ((size_t)q * 64 + pp) * 16 + i0; const float* bi = b_im + ((size_t)q * 64 + pp) * 16 + i0;
        float v[8];
#pragma unroll
        for (int j = 0; j < 8; ++j) { const float x = part == 0 ? (crp * br[j] - cip * bi[j]) : (crp * bi[j] + cip * br[j]);
            const float hi = __uint_as_float(cvt_pk_bf16(x, 0.f) << 16);
            v[j] = lo ? (x - hi) : x; }
        u32x4 o; o.x = cvt_pk_bf16(v[0], v[1]); o.y = cvt_pk_bf16(v[2], v[3]); o.z = cvt_pk_bf16(v[4], v[5]); o.w = cvt_pk_bf16(v[6], v[7]);
        BFR[(q * 8 + nt) * 64 + lane] = o;
    }
#pragma unroll
    for (int ks = 0; ks < 4; ++ks) {
        const int i = lane & 15, pbase = 32 * (ks & 1) + 8 * (lane >> 4), part = ks >> 1;
        const float* src = (part == 0 ? c_re : c_im) + ((size_t)q * 16 + i) * 64 + pbase;
        const float sg = part == 0 ? 1.f : -1.f;
        u32x4 o; o.x = cvt_pk_bf16(sg * src[0], sg * src[1]); o.y = cvt_pk_bf16(sg * src[2], sg * src[3]); o.z = cvt_pk_bf16(sg * src[4], sg * src[5]); o.w = cvt_pk_bf16(sg * src[6], sg * src[7]);
        CFR[(q * 4 + ks) * 64 + lane] = o;
    }
}

__device__ __forceinline__ void adaln_item(const Args& a, int it, LAS float* cact, int tid, int wave, int lane) {
    const int l = it / 96, cc = it % 96;
    const float* c = a.in[1]; const float* cctx = a.in[3]; const float* b_ada = a.in[5];
    float* MOD = (float*)(a.ws + OFF_MOD);
    for (int idx = tid; idx < 33 * 1024; idx += 512) { const int b = idx >> 10, k = idx & 1023; const float v = b < 32 ? c[b * 1024 + k] : cctx[k]; cact[idx] = v / (1.f + expf(-v)); }
    __syncthreads();
    const float* W = a.in[4] + (size_t)l * 1024 * 6144 + cc * 64 + lane;
    float acc[33];
#pragma unroll
    for (int b = 0; b < 33; ++b) acc[b] = 0.f;
    const int kbase = wave * 128;
#pragma unroll 2
    for (int k4 = 0; k4 < 32; ++k4) { const int k = kbase + 4 * k4;
        const float w0 = __builtin_nontemporal_load(W + (size_t)(k + 0) * 6144), w1 = __builtin_nontemporal_load(W + (size_t)(k + 1) * 6144), w2 = __builtin_nontemporal_load(W + (size_t)(k + 2) * 6144), w3 = __builtin_nontemporal_load(W + (size_t)(k + 3) * 6144);
#pragma unroll
        for (int b = 0; b < 33; ++b) { const f32x4 cv = *(const LAS f32x4*)(cact + b * 1024 + k); acc[b] += cv.x * w0 + cv.y * w1 + cv.z * w2 + cv.w * w3; } }
    __syncthreads();
    LAS float* red = cact;
#pragma unroll
    for (int b = 0; b < 33; ++b) red[(wave * 33 + b) * 64 + lane] = acc[b];
    __syncthreads();
    for (int idx = tid; idx < 33 * 64; idx += 512) { const int b = idx >> 6, ln = idx & 63; float s = 0.f;
#pragma unroll
        for (int w = 0; w < 8; ++w) s += red[(w * 33 + b) * 64 + ln];
        MOD[(size_t)(l * 33 + b) * 6144 + cc * 64 + ln] = s + b_ada[l * 6144 + cc * 64 + ln]; }
    __syncthreads();
}

__device__ __forceinline__ void phase_prep(const Args& a, LAS unsigned char* lds, int tid, int wave, int lane) {
    const int G = gridDim.x, gw = blockIdx.x * 8 + wave, NGW = G * 8;
    for (int q = gw; q < 128; q += NGW) ssm_tables(a, q, lane);
    if (blockIdx.x == G - 1) { float* rc = (float*)(a.ws + OFF_ROPE); float* rs = rc + 1024;
        for (int idx = tid; idx < 1024; idx += 512) { const int pidx = idx >> 4, i = idx & 15; const float fr = powf(10000.f, -(float)i / 16.f); float s, c; sincosf((float)pidx * fr, &s, &c); rc[idx] = c; rs[idx] = s; } }
    LAS float* scr = (LAS float*)(lds + wave * 8448);
    constexpr int I_IN = 16 * 56, I_OUT = 16 * 32, I_1 = 16 * 128, I_2 = 64 * 32, I_G = 4 * 8, I_L = I_IN + I_OUT + I_1 + I_2 + I_G;
    for (int it = gw; it < DEPTH * I_L; it += NGW) {
        const int l = it / I_L; int r = it % I_L;
        if (r < I_IN) { transpose_item(a.in[7] + (size_t)l * 1024 * 1792, 1024, 1792, (bf16_t*)(a.ws + OFF_WIN) + (size_t)l * 1792 * 1024, scr, r, lane); continue; } r -= I_IN;
        if (r < I_OUT) { transpose_item(a.in[20] + (size_t)l * 1024 * 1024, 1024, 1024, (bf16_t*)(a.ws + OFF_WOUT) + (size_t)l * 1024 * 1024, scr, r, lane); continue; } r -= I_OUT;
        if (r < I_1) { transpose_item(a.in[21] + (size_t)l * 1024 * 4096, 1024, 4096, (bf16_t*)(a.ws + OFF_W1) + (size_t)l * 4096 * 1024, scr, r, lane); continue; } r -= I_1;
        if (r < I_2) { transpose_item(a.in[22] + (size_t)l * 4096 * 1024, 4096, 1024, (bf16_t*)(a.ws + OFF_W2) + (size_t)l * 1024 * 4096, scr, r, lane); continue; } r -= I_2;
        transpose_item(a.in[18] + (size_t)l * 256 * 256, 256, 256, (bf16_t*)(a.ws + OFF_WGLU) + (size_t)l * 256 * 256, scr, r, lane);
    }
    __syncthreads();
    for (int it = blockIdx.x; it < 4 * 96; it += G) adaln_item(a, it, (LAS float*)lds, tid, wave, lane);
}

typedef _Float16 f16x4 __attribute__((ext_vector_type(4)));
__device__ __forceinline__ unsigned char* h16_row(const Args& a, int r0, bool isctx, bool hop) {
    if (isctx) return a.ws + OFF_HC + (size_t)(r0 - TLAT) * 2048;
    if (!hop) return (unsigned char*)a.out + (size_t)r0 * 2048;
    if (r0 < 41984) return a.ws + OFF_Z + (size_t)536870912 + (size_t)r0 * 2048;
    if (r0 < 58368) return a.ws + OFF_HC + (size_t)(r0 - 41984) * 2048;
    return a.ws + OFF_E + (size_t)(r0 - 58368) * 2048;
}
template <int MODE>
__device__ __forceinline__ void row_pass(const Args& a, int l, int wave, int lane) {
    const int gw = blockIdx.x * 8 + wave, NGW = gridDim.x * 8;
    const float* normg = a.in[6];
    const float* MOD = (const float*)(a.ws + OFF_MOD);
    bf16_t* Abuf = (bf16_t*)(a.ws + OFF_A); const bf16_t* MBuf = (const bf16_t*)(a.ws + OFF_MB);
    const int nrows = (MODE == 0 || l < 3) ? TALL : TLAT;
    const int ntask = nrows >> 3;
    const bool do_a = (MODE != 2) || (l < 3);
    const bool in_f32 = (MODE == 0) || (MODE == 1 && l == 0);
    const bool out_f32 = (MODE == 2 && l == 3);
    for (int task = gw; task < ntask; task += NGW) {
        const int r0 = task << 3;
        const bool isctx = r0 >= TLAT;
        const int b = isctx ? 32 : (r0 >> 11);
        const float* mod = MOD + (size_t)(l * 33 + b) * 6144;
        f32x4 V[4], SA[4], SB[4];
#pragma unroll
        for (int j = 0; j < 4; ++j) { const int col = 4 * lane + 256 * j;
            V[j] = (f32x4){0.f, 0.f, 0.f, 0.f}; SA[j] = V[j]; SB[j] = V[j];
            if (MODE == 0) { SA[j] = *(const f32x4*)(normg + col) * (*(const f32x4*)(mod + 1024 + col) + 1.f); SB[j] = *(const f32x4*)(mod + col); }
            if (MODE == 1) { V[j] = *(const f32x4*)(mod + 2048 + col) * *(const f32x4*)(normg + (l * 4 + 1) * 1024 + col);
                SA[j] = *(const f32x4*)(normg + (l * 4 + 2) * 1024 + col) * (*(const f32x4*)(mod + 4096 + col) + 1.f); SB[j] = *(const f32x4*)(mod + 3072 + col); }
            if (MODE == 2) { V[j] = *(const f32x4*)(mod + 5120 + col) * *(const f32x4*)(normg + (l * 4 + 3) * 1024 + col);
                if (l < 3) { const float* mod2 = MOD + (size_t)((l + 1) * 33 + b) * 6144;
                    SA[j] = *(const f32x4*)(normg + ((l + 1) * 4 + 0) * 1024 + col) * (*(const f32x4*)(mod2 + 1024 + col) + 1.f); SB[j] = *(const f32x4*)(mod2 + col); } }
        }
        const unsigned char* hin0; unsigned char* hout0;
        if (in_f32) hin0 = (const unsigned char*)(isctx ? a.in[2] + (size_t)(r0 - TLAT) * 1024 : a.in[0] + (size_t)r0 * 1024);
        else hin0 = h16_row(a, r0, isctx, MODE == 2 && l == 3);
        if (out_f32) hout0 = (unsigned char*)(a.out + (size_t)r0 * 1024);
        else hout0 = h16_row(a, r0, isctx, MODE == 1 && l == 3);
        const size_t pin = in_f32 ? 4096 : 2048, pout = out_f32 ? 4096 : 2048;
        const bf16_t* mrow0 = MBuf + (size_t)r0 * 1024;
        u32x4 hq[4][4]; u32x2 mq[4][4];
#define RP_LOAD(slot, rr_) do { const unsigned char* hin_ = hin0 + (size_t)(rr_) * pin; \
        _Pragma("unroll") for (int j = 0; j < 4; ++j) { \
            if (in_f32) hq[slot][j] = __builtin_nontemporal_load((const u32x4*)(hin_ + 16 * lane + 1024 * j)); \
            else { const u32x2 t_ = __builtin_nontemporal_load((const u32x2*)(hin_ + 8 * lane + 512 * j)); hq[slot][j] = (u32x4){t_.x, t_.y, 0u, 0u}; } \
            if (MODE != 0) mq[slot][j] = __builtin_nontemporal_load((const u32x2*)(mrow0 + (size_t)(rr_) * 1024 + 4 * lane + 256 * j)); } } while (0)
        RP_LOAD(0, 0); RP_LOAD(1, 1); RP_LOAD(2, 2); RP_LOAD(3, 3);
#pragma unroll
        for (int rr = 0; rr < 8; ++rr) {
            const int r = r0 + rr;
            unsigned char* hout = hout0 + (size_t)rr * pout;
            u32x4 hw[4]; u32x2 mw[4];
#pragma unroll
            for (int j = 0; j < 4; ++j) { hw[j] = hq[rr & 3][j]; if (MODE != 0) mw[j] = mq[rr & 3][j]; }
            if (rr + 4 < 8) RP_LOAD(rr & 3, rr + 4);
            f32x4 h[4];
#pragma unroll
            for (int j = 0; j < 4; ++j) {
                if (in_f32) h[j] = __builtin_bit_cast(f32x4, hw[j]);
                else { const u32x2 t = {hw[j].x, hw[j].y}; h[j] = __builtin_convertvector(__builtin_bit_cast(f16x4, t), f32x4); } }
            if (MODE != 0) {
                f32x4 mv[4]; float ss = 0.f;
#pragma unroll
                for (int j = 0; j < 4; ++j) { const u32x2 w = mw[j];
                    mv[j] = (f32x4){bf_lo(w.x), bf_hi(w.x), bf_lo(w.y), bf_hi(w.y)};
                    if (isctx) { const u32x2 w2 = *(const u32x2*)((const bf16_t*)(a.ws + OFF_E) + (size_t)(r - TLAT) * 1024 + 4 * lane + 256 * j);
                        mv[j] = mv[j] + (f32x4){bf_lo(w2.x), bf_hi(w2.x), bf_lo(w2.y), bf_hi(w2.y)}; }
                    ss += mv[j].x * mv[j].x + mv[j].y * mv[j].y + mv[j].z * mv[j].z + mv[j].w * mv[j].w; }
                ss = wave_sum(ss);
                const float rinv = rsqrtf(ss * (1.f / 1024.f) + 1e-6f);
#pragma unroll
                for (int j = 0; j < 4; ++j) { h[j] = h[j] + V[j] * (mv[j] * rinv);
                    if (out_f32) __builtin_nontemporal_store(h[j], (f32x4*)(hout + 16 * lane + 1024 * j));
                    else __builtin_nontemporal_store(__builtin_bit_cast(u32x2, __builtin_convertvector(h[j], f16x4)), (u32x2*)(hout + 8 * lane + 512 * j)); }
            }
            if (do_a) {
                float ss = 0.f;
#pragma unroll
                for (int j = 0; j < 4; ++j) ss += h[j].x * h[j].x + h[j].y * h[j].y + h[j].z * h[j].z + h[j].w * h[j].w;
                ss = wave_sum(ss);
                const float rinv = rsqrtf(ss * (1.f / 1024.f) + 1e-6f);
#pragma unroll
                for (int j = 0; j < 4; ++j) { const f32x4 o = (h[j] * rinv) * SA[j] + SB[j];
                    u32x2 w; w.x = cvt_pk_bf16(o.x, o.y); w.y = cvt_pk_bf16(o.z, o.w);
                    *(u32x2*)(Abuf + (size_t)r * 1024 + 4 * lane + 256 * j) = w; }
            }
        }
#undef RP_LOAD
    }
}

__device__ __forceinline__ void attn_item(const Args& a, int l, int item, LAS unsigned char* lds, int tid, int wave, int lane) {
    const bf16_t* P = (const bf16_t*)(a.ws + OFF_P);
    bf16_t* MIX = (bf16_t*)(a.ws + OFF_MIX);
    int b, kvh, qb; bool latq;
    if (item < 2048) { latq = true; b = item >> 6; kvh = (item >> 5) & 1; qb = item & 31; }
    else { const int it = item - 2048; latq = false; b = it >> 3; kvh = (it >> 2) & 1; qb = it & 3; }
    const int hq = wave >> 1, qhalf = wave & 1, head = kvh * 4 + hq;
    const int qpos0 = qb * 64 + qhalf * 32;
    const size_t seq0 = latq ? (size_t)b * SEQ : (size_t)TLAT + (size_t)b * CTXL;
    const size_t qrow0 = seq0 + qpos0;
    int lat_lo = 0, nlat = 0;
    if (latq) { lat_lo = qb * 64 - 128; if (lat_lo < 0) lat_lo = 0; int lat_hi = qb * 64 + 192; if (lat_hi > SEQ) lat_hi = SEQ; nlat = (lat_hi - lat_lo) >> 6; }
    const int ntiles = nlat + 4;
    const int lr = lane & 31, h = lane >> 5;
    bf16x8 qf[4];
#pragma unroll
    for (int ks = 0; ks < 4; ++ks) qf[ks] = *(const bf16x8*)(P + (qrow0 + lr) * INW + head * 64 + 16 * ks + 8 * h);
    const float sinkv = a.in[9][l * 8 + head] * 1.4426950408889634f;
    float mrun = sinkv, ls = (h == 0 ? 1.f : 0.f);
    f32x16 Y[2];
#pragma unroll
    for (int i = 0; i < 2; ++i)
#pragma unroll
        for (int e = 0; e < 16; ++e) Y[i][e] = 0.f;
    const int kkey = tid >> 3, kdc = tid & 7;
    u32x4 kreg, vreg;
#define ATT_TROW(i) ((i) < nlat ? (size_t)b * SEQ + lat_lo + 64 * (i) : (size_t)TLAT + (size_t)b * CTXL + 64 * ((i) - nlat))
#define ATT_LOAD(i) do { const size_t trow = ATT_TROW(i); \
        kreg = *(const u32x4*)(P + (trow + kkey) * INW + 512 + kvh * 64 + 8 * kdc); \
        vreg = *(const u32x4*)(P + (trow + lane) * INW + 640 + kvh * 64 + 8 * wave); } while (0)
#define ATT_WRITE(buf) do { *(LAS u32x4*)(lds + (buf) * 9216 + kkey * 144 + kdc * 16) = kreg; \
        LAS bf16_t* vt = (LAS bf16_t*)(lds + 18432 + (buf) * 9216) + (8 * wave) * 72 + lane; \
        vt[0 * 72] = (bf16_t)(vreg.x & 0xffffu); vt[1 * 72] = (bf16_t)(vreg.x >> 16); vt[2 * 72] = (bf16_t)(vreg.y & 0xffffu); vt[3 * 72] = (bf16_t)(vreg.y >> 16); \
        vt[4 * 72] = (bf16_t)(vreg.z & 0xffffu); vt[5 * 72] = (bf16_t)(vreg.z >> 16); vt[6 * 72] = (bf16_t)(vreg.w & 0xffffu); vt[7 * 72] = (bf16_t)(vreg.w >> 16); } while (0)
    ATT_LOAD(0); ATT_WRITE(0);
    __syncthreads();
    for (int i = 0; i < ntiles; ++i) {
        if (i + 1 < ntiles) ATT_LOAD(i + 1);
        const bool lat = i < nlat; const int k0 = lat_lo + 64 * i;
        const bool skip = lat && (k0 > qpos0 + 159 || k0 < qpos0 - 191);
        if (!skip) {
            const LAS unsigned char* Kb = lds + (i & 1) * 9216; const LAS unsigned char* Vb = lds + 18432 + (i & 1) * 9216;
            f32x16 X[2];
#pragma unroll
            for (int i2 = 0; i2 < 2; ++i2)
#pragma unroll
                for (int e = 0; e < 16; ++e) X[i2][e] = 0.f;
#pragma unroll
            for (int ks = 0; ks < 4; ++ks) {
                const bf16x8 kf0 = *(const LAS bf16x8*)(Kb + lr * 144 + (16 * ks + 8 * h) * 2);
                const bf16x8 kf1 = *(const LAS bf16x8*)(Kb + (32 + lr) * 144 + (16 * ks + 8 * h) * 2);
                X[0] = MFMA32(kf0, qf[ks], X[0]); X[1] = MFMA32(kf1, qf[ks], X[1]);
            }
            const bool needmask = lat && (k0 > qpos0 + 65 || k0 < qpos0 - 97);
            if (needmask) {
#pragma unroll
                for (int mt = 0; mt < 2; ++mt) { const int base = (k0 + 32 * mt + 4 * h) - (qpos0 + lr);
#pragma unroll
                    for (int e = 0; e < 16; ++e) { const int diff = base + (e & 3) + 8 * (e >> 2); if (diff > 128 || diff < -128) X[mt][e] = -1e30f; } }
            }
            {
                float mx = X[0][0];
#pragma unroll
                for (int e = 1; e < 16; ++e) mx = fmaxf(mx, X[0][e]);
#pragma unroll
                for (int e = 0; e < 16; ++e) mx = fmaxf(mx, X[1][e]);
                mx = fmaxf(mx, __shfl_xor(mx, 32));
                if (__builtin_amdgcn_ballot_w64(mx > mrun) != 0ull) {
                    const float mnew = fmaxf(mrun, mx);
                    const float alpha = __builtin_amdgcn_exp2f(mrun - mnew);
                    mrun = mnew;
                    ls = ls * alpha;
                    Y[0] = Y[0] * alpha; Y[1] = Y[1] * alpha;
                }
                float sum = 0.f;
#pragma unroll
                for (int mt = 0; mt < 2; ++mt)
#pragma unroll
                    for (int e = 0; e < 16; ++e) { const float p = __builtin_amdgcn_exp2f(X[mt][e] - mrun); X[mt][e] = p; sum += p; }
                ls += sum;
            }
#pragma unroll
            for (int mt = 0; mt < 2; ++mt)
#pragma unroll
                for (int s = 0; s < 2; ++s) {
                    u32x4 w; w.x = cvt_pk_bf16(X[mt][8 * s + 0], X[mt][8 * s + 1]); w.y = cvt_pk_bf16(X[mt][8 * s + 2], X[mt][8 * s + 3]);
                    w.z = cvt_pk_bf16(X[mt][8 * s + 4], X[mt][8 * s + 5]); w.w = cvt_pk_bf16(X[mt][8 * s + 6], X[mt][8 * s + 7]);
                    const bf16x8 pf = __builtin_bit_cast(bf16x8, w);
#pragma unroll
                    for (int dt = 0; dt < 2; ++dt) {
                        const LAS unsigned char* vp = Vb + (32 * dt + lr) * 144 + (32 * mt + 16 * s + 4 * h) * 2;
                        const u32x2 v0 = *(const LAS u32x2*)vp, v1 = *(const LAS u32x2*)(vp + 16);
                        const u32x4 vv = {v0.x, v0.y, v1.x, v1.y};
                        const bf16x8 vf = __builtin_bit_cast(bf16x8, vv);
                        Y[dt] = MFMA32(vf, pf, Y[dt]);
                    }
                }
        }
        if (i + 1 < ntiles) ATT_WRITE((i + 1) & 1);
        __syncthreads();
    }
    {
        const float lt = ls + __shfl_xor(ls, 32);
        const float inv = __builtin_amdgcn_rcpf(lt);
        LAS unsigned char* ot = lds + wave * 4608;
#pragma unroll
        for (int dt = 0; dt < 2; ++dt)
#pragma unroll
            for (int rg = 0; rg < 4; ++rg) { u32x2 w; w.x = cvt_pk_bf16(Y[dt][4 * rg + 0] * inv, Y[dt][4 * rg + 1] * inv); w.y = cvt_pk_bf16(Y[dt][4 * rg + 2] * inv, Y[dt][4 * rg + 3] * inv);
                *(LAS u32x2*)(ot + lr * 144 + (32 * dt + 8 * rg + 4 * h) * 2) = w; }
        LDS_WAIT();
#pragma unroll
        for (int k = 0; k < 4; ++k) { const int row = 8 * k + (lane >> 3), ch = lane & 7;
            const u32x4 w = *(const LAS u32x4*)(ot + row * 144 + ch * 16);
            *(u32x4*)(MIX + (qrow0 + row) * 1024 + head * 64 + ch * 8) = w; }
        __syncthreads();
    }
#undef ATT_TROW
#undef ATT_LOAD
#undef ATT_WRITE
}

__device__ __forceinline__ float gelu_tanh(float y) {
    const float u = 0.7978845608028654f * (y + 0.044715f * y * y * y);
    const float t = 1.f - 2.f * __builtin_amdgcn_rcpf(1.f + __expf(2.f * u));
    return 0.5f * y * (1.f + t);
}
__device__ __forceinline__ void ssm_end_item(const Args& a, int l, int item, LAS unsigned char* lds, int tid, int wave, int lane) {
    const bf16_t* P = (const bf16_t*)(a.ws + OFF_P);
    const f32x4* LAMB = (const f32x4*)(a.ws + OFF_LAMB); const u32x4* BFR = (const u32x4*)(a.ws + OFF_BFR);
    float* E = (float*)(a.ws + OFF_E);
    const int ql = item >> 3, rb = item & 7, dir = ql >> 4, g = ql & 15, q = (l * 2 + dir) * 16 + g;
    const int fr = lane & 15, kq = lane >> 4, th = kq >> 1, j0 = 8 * (kq & 1);
    const int n = 16 * wave + fr, p = n & 63, part = n >> 6;
    float Br[8], Bi[8];
    { const int ntr = wave & 3, nti = ntr + 4, ln = fr + 16 * (kq & 1);
      const u32x4 rh = BFR[(q * 8 + ntr) * 64 + ln], rl = BFR[(q * 8 + ntr) * 64 + ln + 32], ih = BFR[(q * 8 + nti) * 64 + ln], il = BFR[(q * 8 + nti) * 64 + ln + 32];
#pragma unroll
      for (int d = 0; d < 4; ++d) { Br[2 * d] = bf_lo(rh[d]) + bf_lo(rl[d]); Br[2 * d + 1] = bf_hi(rh[d]) + bf_hi(rl[d]);
                                    Bi[2 * d] = bf_lo(ih[d]) + bf_lo(il[d]); Bi[2 * d + 1] = bf_hi(ih[d]) + bf_hi(il[d]); } }
    const f32x4 lam = LAMB[q * 64 + p];
    const float l2r = lam.x * lam.x - lam.y * lam.y, l2i = 2.f * lam.x * lam.y;
    const bool e1 = dir ? (th == 1) : (th == 0);
    float wr = e1 ? lam.x : 1.f, wi = e1 ? lam.y : 0.f;
    f32x4 acc[9];
#pragma unroll
    for (int m = 0; m < 9; ++m) acc[m] = (f32x4){0.f, 0.f, 0.f, 0.f};
    const int rbase = 144 * rb;
    unsigned go[9];
#pragma unroll
    for (int k = 0; k < 9; ++k) { const int idx = tid + 512 * k, row = idx >> 5, pc = idx & 31, r = rbase + row, b = r / 36, ci = r - 36 * b;
        const unsigned row0 = ci < 4 ? (unsigned)(TLAT + b * CTXL + 64 * ci) : (unsigned)(b * SEQ + 64 * (ci - 4));
        go[k] = (row0 + (unsigned)(pc >> 1)) * (unsigned)INW + 1536u + 16u * g + 8u * (pc & 1); }
    u32x4 st[9];
#define SE_LOADQ(kh_) do { const unsigned tb_ = (unsigned)((dir ? 16 * (kh_) : 48 - 16 * (kh_)) * INW); \
        _Pragma("unroll") for (int k = 0; k < 9; ++k) st[k] = *(const u32x4*)(P + (size_t)(go[k] + tb_)); } while (0)
    SE_LOADQ(0);
#pragma unroll 1
    for (int kh = 0; kh < 4; ++kh) {
        bf16x8 bq[8];
#pragma unroll
        for (int i = 0; i < 8; ++i) {
            float v[8];
#pragma unroll
            for (int jj = 0; jj < 8; ++jj) v[jj] = part == 0 ? (wr * Br[jj] - wi * Bi[jj]) : (wr * Bi[jj] + wi * Br[jj]);
            u32x4 o; o.x = cvt_pk_bf16(v[0], v[1]); o.y = cvt_pk_bf16(v[2], v[3]); o.z = cvt_pk_bf16(v[4], v[5]); o.w = cvt_pk_bf16(v[6], v[7]);
            bq[i] = __builtin_bit_cast(bf16x8, o);
            const float nr = wr * l2r - wi * l2i, ni = wr * l2i + wi * l2r; wr = nr; wi = ni;
        }
        __syncthreads();
#pragma unroll
        for (int k = 0; k < 9; ++k) { const int idx = tid + 512 * k; *(LAS u32x4*)(lds + (idx >> 5) * 528 + (idx & 31) * 16) = st[k]; }
        __syncthreads();
        if (kh < 3) SE_LOADQ(kh + 1);
        const LAS unsigned char* ab = lds + fr * 528 + (dir ? th : 14 + th) * 32 + j0 * 2;
        const int tstep = dir ? 64 : -64;
#pragma unroll
        for (int mt = 0; mt < 9; ++mt) {
            bf16x8 af[8];
#pragma unroll
            for (int i = 0; i < 8; ++i) af[i] = *(const LAS bf16x8*)(ab + mt * (16 * 528) + i * tstep);
#pragma unroll
            for (int i = 0; i < 8; ++i) acc[mt] = MFMA16(af[i], bq[i], acc[mt]);
            __builtin_amdgcn_sched_barrier(0);
        }
    }
#undef SE_LOADQ
#pragma unroll
    for (int mt = 0; mt < 9; ++mt)
#pragma unroll
        for (int rg = 0; rg < 4; ++rg) { const int r = rbase + 16 * mt + 4 * kq + rg, b = r / 36, ci = r - 36 * b;
            const int jc = ci < 4 ? ci : ci - 4; const int cdir = dir ? (ci < 4 ? 3 - jc : 35 - jc) : (ci < 4 ? jc : 4 + jc);
            E[(((size_t)((b * 2 + dir) * 36 + cdir) * 16 + g) * 64 + p) * 2 + part] = acc[mt][rg]; }
}

__device__ __forceinline__ void carry_scan(const Args& a, int l, int wave, int lane) {
    const int gw = blockIdx.x * 8 + wave, NGW = gridDim.x * 8;
    const f32x4* LAMB = (const f32x4*)(a.ws + OFF_LAMB);
    const f32x2* E = (const f32x2*)(a.ws + OFF_E); f32x2* E2 = (f32x2*)(a.ws + OFF_E2);
    for (int task = gw; task < 1024; task += NGW) {
        const int b = task >> 5, dir = (task >> 4) & 1, g = task & 15;
        const f32x4 lam = LAMB[((l * 2 + dir) * 16 + g) * 64 + lane];
        const f32x2* Ep = E + ((size_t)((b * 2 + dir) * 36) * 16 + g) * 64 + lane;
        f32x2* Eq = E2 + ((size_t)((b * 2 + dir) * 36) * 16 + g) * 64 + lane;
        float hre = 0.f, him = 0.f;
#pragma unroll 1
        for (int c0 = 0; c0 < 36; c0 += 12) {
            f32x2 e[12];
#pragma unroll
            for (int i = 0; i < 12; ++i) e[i] = Ep[(size_t)(c0 + i) * 1024];
#pragma unroll
            for (int i = 0; i < 12; ++i) { Eq[(size_t)(c0 + i) * 1024] = (f32x2){hre, him};
                const float nre = lam.z * hre - lam.w * him + e[i].x, nim = lam.z * him + lam.w * hre + e[i].y; hre = nre; him = nim; }
        }
    }
}

template <bool PASS2>
__device__ __forceinline__ void ssm_item(const Args& a, int l, int b, int ci, LAS unsigned char* lds, int tid, int wave, int lane) {
    const bf16_t* P = (const bf16_t*)(a.ws + OFF_P);
    bf16_t* MIX = (bf16_t*)(a.ws + OFF_MIX);
    const f32x4* LAMB = (const f32x4*)(a.ws + OFF_LAMB); const bf16x8* BFR = (const bf16x8*)(a.ws + OFF_BFR); const bf16x8* CFR = (const bf16x8*)(a.ws + OFF_CFR);
    f32x2* E = (f32x2*)(a.ws + OFF_E); const f32x2* E2 = (const f32x2*)(a.ws + OFF_E2);
    const bool isctx = ci < 4; const int j = isctx ? ci : ci - 4;
    const size_t row0 = isctx ? (size_t)TLAT + (size_t)b * CTXL + 64 * j : (size_t)b * SEQ + 64 * j;
    const int cf = isctx ? j : 4 + j, cbk = isctx ? 3 - j : 35 - j;
    LAS bf16_t* U = (LAS bf16_t*)lds;
    LAS float* Dw = (LAS float*)(lds + 33792 + wave * 8448);
    LAS bf16_t* Hw = (LAS bf16_t*)(lds + 101376 + wave * 4352);
    f32x4 lamN; f32x2 hinN = {0.f, 0.f}; bf16x8 bfrN[8], cfrN[4];
#define SSM_FETCH(tk) do { const int g_ = 2 * wave + ((tk) >> 1), dir_ = (tk) & 1, q_ = (l * 2 + dir_) * 16 + g_; \
        lamN = LAMB[q_ * 64 + lane]; \
        if (PASS2) hinN = E2[((size_t)((b * 2 + dir_) * 36 + (dir_ ? cbk : cf)) * 16 + g_) * 64 + lane]; \
        _Pragma("unroll") for (int nt = 0; nt < 8; ++nt) bfrN[nt] = BFR[(q_ * 8 + nt) * 64 + lane]; \
        if (PASS2) { _Pragma("unroll") for (int ks = 0; ks < 4; ++ks) cfrN[ks] = CFR[(q_ * 4 + ks) * 64 + lane]; } } while (0)
    SSM_FETCH(0);
#pragma unroll
    for (int i = 0; i < 4; ++i) { const int piece = tid + 512 * i, t = piece >> 5, c16 = piece & 31;
        *(LAS u32x4*)(U + t * 264 + 8 * c16) = *(const u32x4*)(P + (row0 + t) * INW + 1536 + 8 * c16); }
    __syncthreads();
    const int fr = lane & 15, fq = lane >> 4;
    f32x4 acc[4];
#pragma unroll 1
    for (int tk = 0; tk < 4; ++tk) {
        const int g = 2 * wave + (tk >> 1), dir = tk & 1;
        const f32x4 lam = lamN; const float are = lam.x, aim = lam.y, naim = -lam.y;
        float hre = hinN.x, him = hinN.y;
        bf16x8 bfr[8], cfr[4];
#pragma unroll
        for (int nt = 0; nt < 8; ++nt) bfr[nt] = bfrN[nt];
#pragma unroll
        for (int ks = 0; ks < 4; ++ks) cfr[ks] = cfrN[ks];
        if (tk < 3) SSM_FETCH(tk + 1);
        if (dir == 0) {
#pragma unroll
            for (int m = 0; m < 4; ++m) acc[m] = (f32x4){0.f, 0.f, 0.f, 0.f}; }
#pragma unroll 1
        for (int sb = 0; sb < 4; ++sb) {
            const int mt = dir ? 3 - sb : sb;
            const bf16x8 uf = *(const LAS bf16x8*)(U + (16 * mt + fr) * 264 + 16 * g + 8 * (fq & 1));
#pragma unroll
            for (int nt = 0; nt < 8; ++nt) { const f32x4 d = MFMA16(uf, bfr[nt], ((f32x4){0.f, 0.f, 0.f, 0.f}));
#pragma unroll
                for (int r = 0; r < 4; ++r) Dw[(4 * fq + r) * 132 + 16 * nt + fr] = d[r]; }
            LDS_WAIT();
            float dr[16], di[16];
#pragma unroll
            for (int s = 0; s < 8; ++s) { const int t = dir ? 15 - s : s; dr[s] = Dw[t * 132 + lane]; di[s] = Dw[t * 132 + 64 + lane]; }
            LDS_WAIT();
#pragma unroll
            for (int s = 8; s < 16; ++s) { const int t = dir ? 15 - s : s; dr[s] = Dw[t * 132 + lane]; di[s] = Dw[t * 132 + 64 + lane]; }
            LDS_WAIT();
#pragma unroll
            for (int s = 0; s < 16; ++s) {
                float t1, t2, nre, nim;
                asm("v_fma_f32 %0, %1, %2, %3" : "=v"(t1) : "v"(naim), "v"(him), "v"(dr[s]));
                asm("v_fma_f32 %0, %1, %2, %3" : "=v"(t2) : "v"(aim), "v"(hre), "v"(di[s]));
                asm("v_fma_f32 %0, %1, %2, %3" : "=v"(nre) : "v"(are), "v"(hre), "v"(t1));
                asm("v_fma_f32 %0, %1, %2, %3" : "=v"(nim) : "v"(are), "v"(him), "v"(t2));
                hre = nre; him = nim;
                dr[s] = hre; di[s] = him; }
            if (PASS2) {
                unsigned pk[16];
#pragma unroll
                for (int s = 0; s < 16; ++s) pk[s] = cvt_pk_bf16(dr[s], di[s]);
#pragma unroll
                for (int s = 0; s < 16; ++s) { const int t = dir ? 15 - s : s;
                    Hw[t * 136 + lane] = (bf16_t)(pk[s] & 0xffffu); Hw[t * 136 + 64 + lane] = (bf16_t)(pk[s] >> 16);
                    if ((s & 3) == 3) LDS_WAIT(); }
            }
            LDS_WAIT();
            if (PASS2) {
                f32x4 am = acc[0];
                if (mt == 1) am = acc[1]; if (mt == 2) am = acc[2]; if (mt == 3) am = acc[3];
#pragma unroll
                for (int ks = 0; ks < 4; ++ks) { const bf16x8 hf = *(const LAS bf16x8*)(Hw + fr * 136 + 32 * ks + 8 * fq); am = MFMA16(hf, cfr[ks], am); }
                if (mt == 0) acc[0] = am; if (mt == 1) acc[1] = am; if (mt == 2) acc[2] = am; if (mt == 3) acc[3] = am;
                LDS_WAIT();
            }
        }
        if (!PASS2) E[((size_t)((b * 2 + dir) * 36 + (dir ? cbk : cf)) * 16 + g) * 64 + lane] = (f32x2){hre, him};
        if (PASS2 && dir == 1) {
            const int ch = 16 * g + fr; const float dsk = a.in[17][l * 256 + ch];
#pragma unroll
            for (int mt = 0; mt < 4; ++mt)
#pragma unroll
                for (int r = 0; r < 4; ++r) { const int t = 16 * mt + 4 * fq + r; const float u = bf2f(U[t * 264 + ch]);
                    const float y = acc[mt][r] + dsk * u; const float gl = gelu_tanh(y);
                    U[t * 264 + ch] = (bf16_t)(cvt_pk_bf16(gl, 0.f) & 0xffffu); }
        }
    }
#undef SSM_FETCH
    if (PASS2) {
        __syncthreads();
        const bf16_t* WG = (const bf16_t*)(a.ws + OFF_WGLU) + (size_t)l * 65536;
        f32x4 ga[4][2];
#pragma unroll
        for (int m = 0; m < 4; ++m)
#pragma unroll
            for (int n = 0; n < 2; ++n) ga[m][n] = (f32x4){0.f, 0.f, 0.f, 0.f};
        bf16x8 bw[8][2];
#pragma unroll
        for (int ks = 0; ks < 8; ++ks)
#pragma unroll
            for (int nt = 0; nt < 2; ++nt) bw[ks][nt] = *(const bf16x8*)(WG + (size_t)(32 * wave + 16 * nt + fr) * 256 + 32 * ks + 8 * fq);
#pragma unroll
        for (int ks = 0; ks < 8; ++ks) {
#pragma unroll
            for (int mt = 0; mt < 4; ++mt) { const bf16x8 af = *(const LAS bf16x8*)(U + (16 * mt + fr) * 264 + 32 * ks + 8 * fq);
                ga[mt][0] = MFMA16(af, bw[ks][0], ga[mt][0]); ga[mt][1] = MFMA16(af, bw[ks][1], ga[mt][1]); }
        }
#pragma unroll
        for (int nt = 0; nt < 2; ++nt) { const int n = 32 * wave + 16 * nt + fr; const float bg = a.in[19][l * 256 + n];
#pragma unroll
            for (int mt = 0; mt < 4; ++mt)
#pragma unroll
                for (int r = 0; r < 4; ++r) { const int t = 16 * mt + 4 * fq + r; const float gv = bf2f(U[t * 264 + n]);
                    const float z = ga[mt][nt][r] + bg; const float o = gv * __builtin_amdgcn_rcpf(1.f + __expf(-z));
                    MIX[(row0 + t) * 1024 + 768 + n] = (bf16_t)(cvt_pk_bf16(o, 0.f) & 0xffffu); } }
    }
    __syncthreads();
}

__device__ __forceinline__ void conv_phase(const Args& a, int l, int tid) {
    const bf16_t* P = (const bf16_t*)(a.ws + OFF_P);
    bf16_t* MIX = (bf16_t*)(a.ws + OFF_MIX);
    const float* cw = a.in[8] + l * 768;
    const int nrows = l < 3 ? TALL : TLAT;
    const int total = (nrows >> 2) * 32;
    for (int idx = blockIdx.x * 512 + tid; idx < total; idx += gridDim.x * 512) {
        const int r4 = (idx >> 5) * 4, c8 = (idx & 31) * 8;
        const int pos0 = r4 < TLAT ? (r4 & 2047) : ((r4 - TLAT) & 255);
        const int seqlen = r4 < TLAT ? SEQ : CTXL;
        const bool has_prev = pos0 != 0, has_next = (pos0 + 4) != seqlen;
        const bf16_t* pr = P + (size_t)r4 * INW + c8;
        u32x4 cc[6], cx[6], cb[4];
#pragma unroll
        for (int k = 0; k < 6; ++k) { cc[k] = (u32x4){0, 0, 0, 0}; cx[k] = cc[k]; }
        if (has_prev) { cc[0] = *(const u32x4*)(pr - INW + 1024); cx[0] = *(const u32x4*)(pr - INW + 1280); }
#pragma unroll
        for (int k = 1; k < 5; ++k) { cc[k] = *(const u32x4*)(pr + (size_t)(k - 1) * INW + 1024); cx[k] = *(const u32x4*)(pr + (size_t)(k - 1) * INW + 1280); cb[k - 1] = *(const u32x4*)(pr + (size_t)(k - 1) * INW + 768); }
        if (has_next) { cc[5] = *(const u32x4*)(pr + (size_t)4 * INW + 1024); cx[5] = *(const u32x4*)(pr + (size_t)4 * INW + 1280); }
        float w0[8], w1[8], w2[8];
#pragma unroll
        for (int d = 0; d < 8; ++d) { w0[d] = cw[c8 + d]; w1[d] = cw[256 + c8 + d]; w2[d] = cw[512 + c8 + d]; }
        float e[6][8];
#pragma unroll
        for (int k = 0; k < 6; ++k)
#pragma unroll
            for (int d = 0; d < 4; ++d) { e[k][2 * d] = bf_lo(cc[k][d]) * bf_lo(cx[k][d]); e[k][2 * d + 1] = bf_hi(cc[k][d]) * bf_hi(cx[k][d]); }
#pragma unroll
        for (int i = 0; i < 4; ++i) {
            float o[8];
#pragma unroll
            for (int d = 0; d < 4; ++d) {
                o[2 * d]     = bf_lo(cb[i][d]) * (w0[2 * d] * e[i][2 * d] + w1[2 * d] * e[i + 1][2 * d] + w2[2 * d] * e[i + 2][2 * d]);
                o[2 * d + 1] = bf_hi(cb[i][d]) * (w0[2 * d + 1] * e[i][2 * d + 1] + w1[2 * d + 1] * e[i + 1][2 * d + 1] + w2[2 * d + 1] * e[i + 2][2 * d + 1]);
            }
            u32x4 w; w.x = cvt_pk_bf16(o[0], o[1]); w.y = cvt_pk_bf16(o[2], o[3]); w.z = cvt_pk_bf16(o[4], o[5]); w.w = cvt_pk_bf16(o[6], o[7]);
            *(u32x4*)(MIX + (size_t)(r4 + i) * 1024 + 512 + c8) = w;
        }
    }
}

#define XB_TMO      128
#define XB_XCNT(j)  (256  + 64 * (j))
#define XB_XSUB(j)  (1280 + 64 * (j))
#define XB_XGEN(j)  (2304 + 64 * (j))
#define XB_TOP      3328
#define XB_TOPGEN   3392
#define XCD_BAR_WORDS 3456
#define XB_SPIN_CAP (1u << 18)
__device__ __forceinline__ unsigned xb_ld(unsigned* p)              { return __hip_atomic_load(p, __ATOMIC_RELAXED, __HIP_MEMORY_SCOPE_AGENT); }
__device__ __forceinline__ unsigned xb_add(unsigned* p, unsigned v) { return __hip_atomic_fetch_add(p, v, __ATOMIC_RELAXED, __HIP_MEMORY_SCOPE_AGENT); }
__device__ __forceinline__ unsigned xb_xcc_id() { return (unsigned)__builtin_amdgcn_s_getreg((3 << 11) | 20) & 0xFu; }
#define XB_SPIN(cond, bar) do { unsigned _sp = 0; while (cond) { __builtin_amdgcn_s_sleep(1); \
    if ((++_sp & 255u) == 0u) { if (xb_ld(&(bar)[XB_TMO])) break; if (_sp > XB_SPIN_CAP) { atomicAdd(&(bar)[XB_TMO], 1u); break; } } } } while (0)
struct XcdBarrier { unsigned* bar; unsigned x; volatile LAS unsigned* st; };
__device__ __forceinline__ XcdBarrier xcd_barrier_post(unsigned* bar, volatile LAS unsigned* st) {
    XcdBarrier b; b.bar = bar; b.x = xb_xcc_id(); b.st = st;
    if (threadIdx.x == 0) (void)xb_add(&bar[XB_XCNT(b.x)], 1u);
    return b;
}
__device__ __forceinline__ void xcd_barrier_complete(unsigned* bar, unsigned x, unsigned& nloc, unsigned& nx) {
    const unsigned G = gridDim.x * gridDim.y * gridDim.z;
    unsigned sum, cnt, mine, sp = 0u;
    for (;;) {
        sum = 0u; cnt = 0u; mine = 0u;
#pragma unroll
        for (unsigned j = 0; j < 16; ++j) { const unsigned c = xb_ld(&bar[XB_XCNT(j)]); sum += c; cnt += (c > 0u) ? 1u : 0u; mine = (j == x) ? c : mine; }
        if (sum == G) break;
        __builtin_amdgcn_s_sleep(1);
        if ((++sp & 255u) == 0u) { if (xb_ld(&bar[XB_TMO])) break; if (sp > XB_SPIN_CAP) { atomicAdd(&bar[XB_TMO], 1u); break; } }
    }
    nloc = mine > 0u ? mine : 1u; nx = cnt > 0u ? cnt : 1u;
}
__device__ __forceinline__ void xcd_barrier(const XcdBarrier& b) {
    asm volatile("s_waitcnt vmcnt(0)" ::: "memory");
    __syncthreads();
    if (threadIdx.x == 0) {
        unsigned* bar = b.bar;
        __builtin_amdgcn_s_waitcnt(0);
        unsigned nloc = b.st[0], nx = b.st[1];
        if (nloc == 0u) { xcd_barrier_complete(bar, b.x, nloc, nx); b.st[0] = nloc; b.st[1] = nx; }
        const unsigned old = xb_add(&bar[XB_XSUB(b.x)], 1u);
        const unsigned gen = old / nloc;
        if (old + 1u == (gen + 1u) * nloc) {
            __builtin_amdgcn_fence(__ATOMIC_RELEASE, "agent");
            asm volatile("s_waitcnt vmcnt(0)" ::: "memory");
            const unsigned og = xb_add(&bar[XB_TOP], 1u);
            const unsigned tg = og / nx;
            if (og + 1u == (tg + 1u) * nx) xb_add(&bar[XB_TOPGEN], 1u);
            else XB_SPIN(xb_ld(&bar[XB_TOPGEN]) == tg, bar);
            __builtin_amdgcn_fence(__ATOMIC_ACQUIRE, "agent");
            xb_add(&bar[XB_XGEN(b.x)], 1u);
            asm volatile("s_waitcnt vmcnt(0)" ::: "memory");
        } else {
            XB_SPIN(xb_ld(&bar[XB_XGEN(b.x)]) == gen, bar);
            __builtin_amdgcn_fence(__ATOMIC_ACQUIRE, "agent");
            asm volatile("s_waitcnt vmcnt(0)" ::: "memory");
        }
    }
    __syncthreads();
}

__global__ void __launch_bounds__(512) mk_fwd(Args a) {
    extern __shared__ __attribute__((aligned(16))) unsigned char smem[];
    LAS unsigned char* lds = (LAS unsigned char*)smem;
    cg::grid_group grid = cg::this_grid();
    const int G = gridDim.x;
#define FRESH() const int tid = fresh_tid(); const int lane = tid & 63; const int wave = __builtin_amdgcn_readfirstlane(tid >> 6); (void)tid; (void)lane; (void)wave
    const int lo = a.ph_lo, hi = a.ph_hi;
#define IN(k) (lo <= (k) && (k) < hi)
    volatile LAS unsigned* xb_st = (volatile LAS unsigned*)(lds + LDS_BYTES - 16);
    if (threadIdx.x < 4) xb_st[threadIdx.x] = 0u;
    __syncthreads();
    const XcdBarrier xbar = xcd_barrier_post((unsigned*)(a.ws + OFF_BAR), xb_st);
#define SYNC(k) do { if ((k) + 1 < hi) { if ((k) == 0) grid.sync(); else xcd_barrier(xbar); } } while (0)
    if (IN(0)) { { FRESH(); phase_prep(a, lds, tid, wave, lane); } SYNC(0); }
    if (IN(1)) { { FRESH(); row_pass<0>(a, 0, wave, lane); } SYNC(1); }
#pragma unroll 1
    for (int l = 0; l < DEPTH; ++l) {
        const int ph = 2 + 9 * l;
        const int Mrows = l < 3 ? TALL : TLAT;
        if (IN(ph + 0)) {
            pg8::Gemm g{(const bf16_t*)(a.ws + OFF_A), (const bf16_t*)(a.ws + OFF_WIN) + (size_t)l * INW * 1024, 1024};
            pg8::Order S; S.nM = Mrows / 256; S.nN = 7; S.nwg = S.nM * 7; S.G = G; S.c = blockIdx.x; S.extra = l < 3 ? 0 : 64; S.split = 0;
            pg8::EpiP E{(bf16_t*)(a.ws + OFF_P), (const float*)(a.ws + OFF_ROPE), (const float*)(a.ws + OFF_ROPE) + 1024};
            for (int rep = 0; rep < REP_GEMM; ++rep) pg8::gemm_phase<pg8::EpiP>(lds, g, S, E);
            SYNC(ph + 0);
        }
        if (IN(ph + 1)) {
            FRESH();
            for (int rep = 0; rep < REP_MIX; ++rep) {
                for (int it = blockIdx.x; it < 256; it += G) ssm_end_item(a, l, it, lds, tid, wave, lane);
                conv_phase(a, l, tid);
            }
            SYNC(ph + 1);
        }
        if (IN(ph + 2)) {
            FRESH();
            carry_scan(a, l, wave, lane);
            SYNC(ph + 2);
        }
        if (IN(ph + 3)) {
            FRESH();
            const int nit = l < 3 ? 1152 : 1024, nattn = l < 3 ? 2304 : 2048;
            for (int it = blockIdx.x; it < nit; it += G) {
                int b, ci; if (l < 3) { b = it / 36; ci = it % 36; } else { b = it >> 5; ci = 4 + (it & 31); }
                ssm_item<true>(a, l, b, ci, lds, tid, wave, lane);
            }
            {
                for (int it = blockIdx.x; it < 2048; it += G) attn_item(a, l, it, lds, tid, wave, lane);
                if (nattn > 2048 && G == 256) { if (blockIdx.x >= 128) { const int e = 2048 + 2 * ((int)blockIdx.x - 128); attn_item(a, l, e, lds, tid, wave, lane); attn_item(a, l, e + 1, lds, tid, wave, lane); } }
                else for (int it = 2048 + blockIdx.x; it < nattn; it += G) attn_item(a, l, it, lds, tid, wave, lane);
            }
            SYNC(ph + 3);
        }
        if (IN(ph + 4)) {
            pg8::Gemm g{(const bf16_t*)(a.ws + OFF_MIX), (const bf16_t*)(a.ws + OFF_WOUT) + (size_t)l * 1024 * 1024, 1024};
            pg8::Order S; S.nM = 256; S.nN = 4; S.nwg = 1024; S.G = G; S.c = blockIdx.x; S.extra = l < 3 ? 256 : 0; S.split = 1;
            pg8::EpiBf<0> E{(bf16_t*)(a.ws + OFF_MB), 1024, (bf16_t*)(a.ws + OFF_E)};
            for (int rep = 0; rep < REP_GEMM; ++rep) pg8::gemm_phase<pg8::EpiBf<0>>(lds, g, S, E);
            SYNC(ph + 4);
        }
        if (IN(ph + 5)) { { FRESH(); row_pass<1>(a, l, wave, lane); } SYNC(ph + 5); }
        if (IN(ph + 6)) {
            pg8::Gemm g{(const bf16_t*)(a.ws + OFF_A), (const bf16_t*)(a.ws + OFF_W1) + (size_t)l * DFF * 1024, 1024};
            pg8::Order S; S.nM = Mrows / 256; S.nN = 16; S.nwg = S.nM * 16; S.G = G; S.c = blockIdx.x; S.extra = 0; S.split = 0;
            pg8::EpiBf<1> E{(bf16_t*)(a.ws + OFF_Z), DFF, nullptr};
            for (int rep = 0; rep < REP_GEMM; ++rep) pg8::gemm_phase<pg8::EpiBf<1>>(lds, g, S, E);
            SYNC(ph + 6);
        }
        if (IN(ph + 7)) {
            pg8::Gemm g{(const bf16_t*)(a.ws + OFF_Z), (const bf16_t*)(a.ws + OFF_W2) + (size_t)l * 1024 * DFF, DFF};
            pg8::Order S; S.nM = 256; S.nN = 4; S.nwg = 1024; S.G = G; S.c = blockIdx.x; S.extra = l < 3 ? 256 : 0; S.split = 1;
            pg8::EpiBf<0> E{(bf16_t*)(a.ws + OFF_MB), 1024, (bf16_t*)(a.ws + OFF_E)};
            for (int rep = 0; rep < REP_GEMM; ++rep) pg8::gemm_phase<pg8::EpiBf<0>>(lds, g, S, E);
            SYNC(ph + 7);
        }
        if (IN(ph + 8)) { { FRESH(); row_pass<2>(a, l, wave, lane); } SYNC(ph + 8); }
    }
#undef IN
#undef SYNC
#undef FRESH
}

extern "C" void kernel_launch(void* const* d_in, const int* in_sizes, int n_in, void* d_out, int out_size, void* d_ws, size_t ws_size, hipStream_t stream) {
    static int grid = 0;
    if (grid == 0) {
        if (n_in != 23 || out_size != TLAT * DM || ws_size < WS_END) { fprintf(stderr, "kernel_launch: unexpected shapes (n_in %d out %d ws %zu need %zu)\n", n_in, out_size, ws_size, (size_t)WS_END); grid = -1; return; }
        int dev = 0, cus = 0, per_cu = 0;
        (void)hipGetDevice(&dev);
        (void)hipDeviceGetAttribute(&cus, hipDeviceAttributeMultiprocessorCount, dev);
        if (hipFuncSetAttribute((const void*)mk_fwd, hipFuncAttributeMaxDynamicSharedMemorySize, LDS_BYTES) != hipSuccess) { fprintf(stderr, "kernel_launch: hipFuncSetAttribute failed\n"); grid = -1; return; }
        (void)hipOccupancyMaxActiveBlocksPerMultiprocessor(&per_cu, (const void*)mk_fwd, 512, LDS_BYTES);
        if (per_cu < 1) { fprintf(stderr, "kernel_launch: occupancy query says %d blocks per CU\n", per_cu); per_cu = 1; }
        (void)hipGetLastError();
        grid = cus;
    }
    if (grid < 0) return;
    Args a{};
    for (int i = 0; i < 23; ++i) a.in[i] = (const float*)d_in[i];
    a.out = (float*)d_out; a.ws = (unsigned char*)d_ws; a.ph_lo = 0; a.ph_hi = 38;
    if (hipMemsetAsync((unsigned char*)d_ws + OFF_BAR, 0, XCD_BAR_WORDS * sizeof(unsigned), stream) != hipSuccess) { fprintf(stderr, "kernel_launch: hipMemsetAsync of the barrier words failed\n"); return; }
    void* args[] = {&a};
    hipError_t e = hipLaunchCooperativeKernel((const void*)mk_fwd, dim3(grid), dim3(512), args, LDS_BYTES, stream);
    if (e != hipSuccess) fprintf(stderr, "cooperative launch failed: %s (grid %d)\n", hipGetErrorString(e), grid);
}
```

```cpp
#include <hip/hip_runtime.h>
#include <hip/hip_cooperative_groups.h>
#include <cstdio>
#include <cstdint>
namespace cg = cooperative_groups;

#define LAS __attribute__((address_space(3)))
typedef unsigned short bf16_t;
typedef short bf16x8 __attribute__((ext_vector_type(8)));
typedef float f32x4 __attribute__((ext_vector_type(4)));
typedef float f32x2 __attribute__((ext_vector_type(2)));
typedef float f32x16 __attribute__((ext_vector_type(16)));
typedef unsigned u32x4 __attribute__((ext_vector_type(4)));
typedef unsigned u32x2 __attribute__((ext_vector_type(2)));

constexpr int DM = 1024, SEQ = 2048, NB = 32, CTXL = 256, DEPTH = 4;
constexpr int TLAT = NB * SEQ, TCTX = NB * CTXL, TALL = TLAT + TCTX;
constexpr int INW = 1792, DFF = 4096;
constexpr int LDS_BYTES = 139264;
#ifndef REP_GEMM
#define REP_GEMM 1
#endif
#ifndef REP_MIX
#define REP_MIX 1
#endif

constexpr size_t OFF_MOD  = 0;
constexpr size_t OFF_ROPE = OFF_MOD + (size_t)4 * 33 * 6144 * 4;
constexpr size_t OFF_LAMB = OFF_ROPE + 8192;
constexpr size_t OFF_BFR  = OFF_LAMB + 131072;
constexpr size_t OFF_CFR  = OFF_BFR + 1048576;
constexpr size_t OFF_E    = OFF_CFR + 524288;
constexpr size_t OFF_WIN  = OFF_E + 18874368;
constexpr size_t OFF_WOUT = OFF_WIN + 14680064;
constexpr size_t OFF_W1   = OFF_WOUT + 8388608;
constexpr size_t OFF_W2   = OFF_W1 + 33554432;
constexpr size_t OFF_WGLU = OFF_W2 + 33554432;
constexpr size_t OFF_HC   = OFF_WGLU + 524288;
constexpr size_t OFF_A    = OFF_HC + 33554432;
constexpr size_t OFF_MB   = OFF_A + 150994944;
constexpr size_t OFF_Z    = OFF_MB + 150994944;
constexpr size_t OFF_P    = OFF_Z;
constexpr size_t OFF_MIX  = OFF_Z + 264241152;
constexpr size_t OFF_E2   = OFF_Z + 603979776;
constexpr size_t OFF_BAR  = OFF_E2 + 18874368;
constexpr size_t WS_END   = OFF_BAR + 16384;

struct Args { const float* in[23]; float* out; unsigned char* ws; int ph_lo, ph_hi; };

__device__ __forceinline__ unsigned cvt_pk_bf16(float lo, float hi) { unsigned r; asm("v_cvt_pk_bf16_f32 %0, %1, %2" : "=v"(r) : "v"(lo), "v"(hi)); return r; }
__device__ __forceinline__ float bf_lo(unsigned u) { return __uint_as_float(u << 16); }
__device__ __forceinline__ float bf_hi(unsigned u) { return __uint_as_float(u & 0xffff0000u); }
__device__ __forceinline__ float bf2f(bf16_t x) { return __uint_as_float(((unsigned)x) << 16); }
#define DPP_ADD(v, ctrl) ((v) + __builtin_bit_cast(float, __builtin_amdgcn_update_dpp(0, __builtin_bit_cast(int, (v)), (ctrl), 0xF, 0xF, true)))
__device__ __forceinline__ float wave_sum(float v) {
    v = DPP_ADD(v, 0xB1);
    v = DPP_ADD(v, 0x4E);
    v = DPP_ADD(v, 0x141);
    v = DPP_ADD(v, 0x140);
    const int iv = __builtin_bit_cast(int, v);
    const float s0 = __builtin_bit_cast(float, __builtin_amdgcn_readlane(iv, 0)), s1 = __builtin_bit_cast(float, __builtin_amdgcn_readlane(iv, 16));
    const float s2 = __builtin_bit_cast(float, __builtin_amdgcn_readlane(iv, 32)), s3 = __builtin_bit_cast(float, __builtin_amdgcn_readlane(iv, 48));
    return (s0 + s1) + (s2 + s3);
}
#define LDS_WAIT() asm volatile("s_waitcnt lgkmcnt(0)" ::: "memory")
__device__ __forceinline__ int fresh_tid() { int t = threadIdx.x; asm volatile("" : "+v"(t)); return t; }
#define MFMA16(a, b, c) __builtin_amdgcn_mfma_f32_16x16x32_bf16((a), (b), (c), 0, 0, 0)
#define MFMA32(a, b, c) __builtin_amdgcn_mfma_f32_32x32x16_bf16((a), (b), (c), 0, 0, 0)

namespace pg8 {
constexpr int BM = 256, BK = 64, HALF = 128, HTB = HALF * BK * 2, STAGE_BYTES = 8 * HTB, NXCD = 8, WGM = 8;
__device__ __forceinline__ int lds_byte(int r, int c) { const int st = (r >> 4) * 2 + (c >> 5), rr = r & 15, cc = c & 31, ob = rr * 64 + cc * 2; return st * 1024 + (ob ^ (((ob >> 9) & 1) << 5)); }
__device__ __forceinline__ void stage_rc(int b, int& R, int& C) { const int st = b / 1024, sb = b % 1024, swz = sb ^ (((sb >> 9) & 1) << 5); R = (st >> 1) * 16 + swz / 64; C = (st & 1) * 32 + (swz % 64) / 2; }
__device__ __forceinline__ int perm32(int rho) { const int n = rho >> 4, i = rho & 15; return 8 * (i >> 2) + 4 * n + (i & 3); }
struct Unit { int pm, pn, half, kh; };
struct Gemm { const bf16_t* A; const bf16_t* Bt; int K; };
struct Order {
    int nM, nN, nwg, G, c, extra, split;
    __device__ __forceinline__ bool next(int i, Unit& u) const {
        const int L = i * G + c;
        u.half = 0; u.kh = 0;
        if (L >= nwg + extra) return false;
        if (L >= nwg) { const int e = L - nwg;
            if (split) { const int uu = e >> 1; u.half = 1; u.kh = e & 1; u.pm = nM + uu / nN; u.pn = uu % nN; return true; }
            u.pm = nM + (e >> 1); u.pn = (e & 1) ? 6 : 2; return true; }
        int wgid = L; { const int q = nwg / NXCD, r = nwg % NXCD, xcd = wgid % NXCD, off = wgid / NXCD; wgid = (xcd < r ? xcd * (q + 1) : r * (q + 1) + (xcd - r) * q) + off; }
        const int nig = WGM * nN, gid = wgid / nig, fm = gid * WGM, gsz = (nM - fm) < WGM ? (nM - fm) : WGM;
        u.pm = fm + ((wgid % nig) % gsz); u.pn = (wgid % nig) / gsz; return true;
    }
};
template <int ACT>
struct EpiBf {
    static constexpr bool PERM = true;
    bf16_t* O; int ldc; bf16_t* O2;
    __device__ __forceinline__ void operator()(const f32x4 (&acc)[2][2][4][2], const Unit& u, int wr, int wc, int fr, int fq) const {
        const int row0 = u.pm * BM + wr * 64 + fr, col0 = u.pn * BM + wc * 32 + 8 * fq;
        bf16_t* base = u.kh ? O2 - (size_t)TLAT * ldc : O;
#pragma unroll
        for (int ai = 0; ai < 2; ++ai)
#pragma unroll
            for (int m = 0; m < 4; ++m) { bf16_t* rowp = base + (size_t)(row0 + ai * HALF + m * 16) * ldc + col0;
#pragma unroll
                for (int bj = 0; bj < 2; ++bj) { f32x4 v0 = acc[ai][bj][m][0], v1 = acc[ai][bj][m][1];
                    if (ACT == 1) { v0.x = fmaxf(v0.x, 0.f); v0.y = fmaxf(v0.y, 0.f); v0.z = fmaxf(v0.z, 0.f); v0.w = fmaxf(v0.w, 0.f); v0 = v0 * v0;
                                    v1.x = fmaxf(v1.x, 0.f); v1.y = fmaxf(v1.y, 0.f); v1.z = fmaxf(v1.z, 0.f); v1.w = fmaxf(v1.w, 0.f); v1 = v1 * v1; }
                    u32x4 w; w.x = cvt_pk_bf16(v0.x, v0.y); w.y = cvt_pk_bf16(v0.z, v0.w); w.z = cvt_pk_bf16(v1.x, v1.y); w.w = cvt_pk_bf16(v1.z, v1.w);
                    *(u32x4*)(rowp + bj * HALF) = w; } }
    }
};
struct EpiP {
    static constexpr bool PERM = true;
    bf16_t* P; const float* rc; const float* rs;
    __device__ __forceinline__ void operator()(const f32x4 (&acc)[2][2][4][2], const Unit& u, int wr, int wc, int fr, int fq) const {
        const int row0 = u.pm * BM + wr * 64 + fr, col0 = u.pn * BM + wc * 32 + 8 * fq;
        const bool lat = u.pm < 256;
        const float qs = (u.pn < 2) ? 0.125f * 1.4426950408889634f : 1.f;
        const bool rope_any = lat && (u.pn <= 2);
        const float sgn = fq < 2 ? -1.f : 1.f;
        const bool colrot = (wc & 1) != 0;
        f32x4 c0[4], c1[4], s0[4], s1[4];
#pragma unroll
        for (int k = 0; k < 4; ++k) { c0[k] = (f32x4){1.f, 1.f, 1.f, 1.f}; c1[k] = c0[k]; s0[k] = (f32x4){0.f, 0.f, 0.f, 0.f}; s1[k] = s0[k]; }
        if (rope_any) {
#pragma unroll
            for (int k = 0; k < 4; ++k) {
                if (colrot || k < 2) {
                    const int row = colrot ? row0 + k * 16 : row0 + k * HALF; const int pos = row & 2047; const int pidx = colrot ? (pos & 63) : (pos >> 6); const int o = pidx * 16 + 8 * (fq & 1);
                    c0[k] = *(const f32x4*)(rc + o); c1[k] = *(const f32x4*)(rc + o + 4); s0[k] = *(const f32x4*)(rs + o) * sgn; s1[k] = *(const f32x4*)(rs + o + 4) * sgn; } }
        }
#pragma unroll
        for (int ai = 0; ai < 2; ++ai)
#pragma unroll
            for (int m = 0; m < 4; ++m) { const int row = row0 + ai * HALF + m * 16; bf16_t* rowp = P + (size_t)row * INW + col0;
                const f32x4 cc0 = colrot ? c0[m] : c0[ai], cc1 = colrot ? c1[m] : c1[ai], ss0 = colrot ? s0[m] : s0[ai], ss1 = colrot ? s1[m] : s1[ai];
#pragma unroll
                for (int bj = 0; bj < 2; ++bj) { f32x4 v0 = acc[ai][bj][m][0], v1 = acc[ai][bj][m][1];
                    const bool rope = lat && (u.pn < 2 || (u.pn == 2 && bj == 0));
                    if (rope) { f32x4 p0, p1;
#pragma unroll
                        for (int e = 0; e < 4; ++e) { p0[e] = __shfl_xor(v0[e], 32); p1[e] = __shfl_xor(v1[e], 32); }
                        v0 = v0 * cc0 + p0 * ss0; v1 = v1 * cc1 + p1 * ss1; }
                    v0 = v0 * qs; v1 = v1 * qs;
                    u32x4 w; w.x = cvt_pk_bf16(v0.x, v0.y); w.y = cvt_pk_bf16(v0.z, v0.w); w.z = cvt_pk_bf16(v1.x, v1.y); w.w = cvt_pk_bf16(v1.z, v1.w);
                    *(u32x4*)(rowp + bj * HALF) = w; } }
    }
};

template <class Epi>
__device__ __forceinline__ void gemm_phase(LAS unsigned char* lds, const Gemm g, const Order& S, const Epi& E) {
    const int tid = fresh_tid(), wid = __builtin_amdgcn_readfirstlane(tid >> 6), lane = tid & 63, wr = wid >> 2, wc = wid & 3, fr = lane & 15, fq = lane >> 4;
    const int K = g.K, nt = K / BK;
    unsigned voffA[2], voffB[2];
#pragma unroll
    for (int i = 0; i < 2; ++i) { int R, C; stage_rc(tid * 16 + i * 8192, R, C); const int Rb = Epi::PERM ? ((R & ~31) + perm32(R & 31)) : R;
        voffA[i] = (unsigned)(R * K + C) * 2u; voffB[i] = (unsigned)(Rb * K + C) * 2u; }
    const size_t kstep = (size_t)(BK * 2);
    const size_t hstep = (size_t)HALF * K * 2;
    const size_t tstep = 2 * hstep;
    const unsigned ldsw = (unsigned)wid * 1024u;
    const int aoff = lds_byte(wr * 64 + fr, fq * 8), boff = lds_byte(wc * 32 + fr, fq * 8);
#define PG8_SA(b, h) (((b) * 2 + (h)) * HTB)
#define PG8_SB(b, h) ((4 + (b) * 2 + (h)) * HTB)
#define PG8_STAGE(bufoff, gbase, voff) do { _Pragma("unroll") for (int _i = 0; _i < 2; ++_i) \
        __builtin_amdgcn_global_load_lds((const unsigned*)((const char*)(gbase) + (voff)[_i]), (LAS unsigned*)(lds + (bufoff) + ldsw + _i * 8192), 16, 0, 0); } while (0)
#define PG8_LDA(dst, b, h) do { _Pragma("unroll") for (int m = 0; m < 4; ++m) _Pragma("unroll") for (int k = 0; k < 2; ++k) dst[m][k] = *(const LAS bf16x8*)(lds + PG8_SA(b, h) + aoff + m * 2048 + k * 1024); } while (0)
#define PG8_LDB(dst, b, h) do { _Pragma("unroll") for (int n = 0; n < 2; ++n) _Pragma("unroll") for (int k = 0; k < 2; ++k) dst[n][k] = *(const LAS bf16x8*)(lds + PG8_SB(b, h) + boff + n * 2048 + k * 1024); } while (0)
#define PG8_MMA(ai, bj, At, Bt) do { __builtin_amdgcn_s_setprio(1); _Pragma("unroll") for (int m = 0; m < 4; ++m) _Pragma("unroll") for (int n = 0; n < 2; ++n) _Pragma("unroll") for (int k = 0; k < 2; ++k) \
        acc[ai][bj][m][n] = __builtin_amdgcn_mfma_f32_16x16x32_bf16(Bt[n][k], At[m][k], acc[ai][bj][m][n], 0, 0, 0); __builtin_amdgcn_s_setprio(0); } while (0)
#define PG8_WAIT_V(n) asm volatile("s_waitcnt vmcnt(" #n ")" ::: "memory")
#define PG8_WAIT_L(n) asm volatile("s_waitcnt lgkmcnt(" #n ")" ::: "memory")
#define PG8_BAR __builtin_amdgcn_s_barrier()
#define PG8_SCHED __builtin_amdgcn_sched_barrier(0)
    Unit cur, nxt; int ui = 0;
    if (!S.next(0, cur)) return;
    f32x4 acc[2][2][4][2];
#pragma unroll
    for (int a = 0; a < 2; ++a)
#pragma unroll
        for (int b = 0; b < 2; ++b)
#pragma unroll
            for (int m = 0; m < 4; ++m)
#pragma unroll
                for (int n = 0; n < 2; ++n) acc[a][b][m][n] = (f32x4){0.f, 0.f, 0.f, 0.f};
    bf16x8 At[4][2], B0[2][2], B1[2][2];
    const size_t khoff = (size_t)K;
    const char* cA = (const char*)g.A + (size_t)cur.pm * tstep + (cur.kh ? khoff : 0); const char* cB = (const char*)g.Bt + (size_t)cur.pn * tstep + (cur.kh ? khoff : 0);
    PG8_STAGE(PG8_SB(0, 0), cB, voffB); PG8_STAGE(PG8_SB(0, 1), cB + hstep, voffB); PG8_STAGE(PG8_SA(0, 0), cA, voffA); PG8_STAGE(PG8_SA(0, 1), cA + hstep, voffA);
    if (wr == 1) PG8_BAR;
    PG8_WAIT_V(2); PG8_BAR;
    PG8_STAGE(PG8_SB(1, 0), cB + kstep, voffB); PG8_STAGE(PG8_SA(1, 0), cA + kstep, voffA); PG8_STAGE(PG8_SB(1, 1), cB + hstep + kstep, voffB);
    PG8_WAIT_V(6); PG8_BAR;
    for (;;) {
        const bool has_next = S.next(ui + 1, nxt);
        const char* nA = has_next ? (const char*)g.A + (size_t)nxt.pm * tstep + (nxt.kh ? khoff : 0) : cA; const char* nB = has_next ? (const char*)g.Bt + (size_t)nxt.pn * tstep + (nxt.kh ? khoff : 0) : cB;
        const int cnt = cur.half ? (nt >> 1) : nt;
        for (int t = 0; t < cnt; t += 2) {
            const bool last = (t == cnt - 2);
            const char* a1 = cA + (size_t)(t + 1) * kstep;
            const char* a2 = last ? nA : cA + (size_t)(t + 2) * kstep; const char* b2 = last ? nB : cB + (size_t)(t + 2) * kstep;
            const char* a3 = a2 + kstep; const char* b3 = b2 + kstep;
            PG8_LDB(B0, 0, 0); PG8_LDB(B1, 0, 1); PG8_SCHED; PG8_LDA(At, 0, 0); PG8_STAGE(PG8_SA(1, 1), a1 + hstep, voffA);
            PG8_WAIT_V(8); PG8_WAIT_L(0); PG8_BAR; PG8_MMA(0, 0, At, B0); PG8_MMA(0, 1, At, B1); PG8_BAR; PG8_SCHED;
            PG8_LDA(At, 0, 1); PG8_STAGE(PG8_SB(0, 0), b2, voffB); PG8_STAGE(PG8_SB(0, 1), b2 + hstep, voffB); PG8_STAGE(PG8_SA(0, 0), a2, voffA);
            PG8_WAIT_V(8); PG8_WAIT_L(0); PG8_BAR; PG8_MMA(1, 0, At, B0); PG8_MMA(1, 1, At, B1); PG8_BAR; PG8_SCHED;
            PG8_LDB(B0, 1, 0); PG8_LDB(B1, 1, 1); PG8_SCHED; PG8_LDA(At, 1, 0); PG8_STAGE(PG8_SA(0, 1), a2 + hstep, voffA);
            PG8_WAIT_V(8); PG8_WAIT_L(0); PG8_BAR; PG8_MMA(0, 0, At, B0); PG8_MMA(0, 1, At, B1); PG8_BAR; PG8_SCHED;
            PG8_LDA(At, 1, 1); PG8_STAGE(PG8_SB(1, 0), b3, voffB); PG8_STAGE(PG8_SB(1, 1), b3 + hstep, voffB); PG8_STAGE(PG8_SA(1, 0), a3, voffA);
            PG8_WAIT_V(8); PG8_WAIT_L(0); PG8_BAR; PG8_MMA(1, 0, At, B0); PG8_MMA(1, 1, At, B1); PG8_BAR; PG8_SCHED;
        }
        if (wr == 0) PG8_BAR;
        E(acc, cur, wr, wc, fr, fq);
        if (!has_next) break;
#pragma unroll
        for (int a = 0; a < 2; ++a)
#pragma unroll
            for (int b = 0; b < 2; ++b)
#pragma unroll
                for (int m = 0; m < 4; ++m)
#pragma unroll
                    for (int n = 0; n < 2; ++n) acc[a][b][m][n] = (f32x4){0.f, 0.f, 0.f, 0.f};
        cur = nxt; cA = nA; cB = nB; ++ui;
        if (wr == 1) PG8_BAR;
    }
    PG8_WAIT_V(0);
    PG8_BAR;
#undef PG8_SA
#undef PG8_SB
#undef PG8_STAGE
#undef PG8_LDA
#undef PG8_LDB
#undef PG8_MMA
#undef PG8_WAIT_V
#undef PG8_WAIT_L
#undef PG8_BAR
#undef PG8_SCHED
}
}

__device__ __forceinline__ void transpose_item(const float* W, int K, int N, bf16_t* WT, LAS float* scr, int item, int lane) {
    const int nblk = N / 32, kb = item / nblk, nb = item % nblk, k0 = 64 * kb, n0 = 32 * nb;
#pragma unroll 8
    for (int i = 0; i < 32; ++i) { const int kk = 2 * i + (lane >> 5); scr[kk * 33 + (lane & 31)] = __builtin_nontemporal_load(W + (size_t)(k0 + kk) * N + n0 + (lane & 31)); }
    LDS_WAIT();
    const int c = lane & 7;
#pragma unroll
    for (int j = 0; j < 4; ++j) { const int n = (lane >> 3) + 8 * j; const LAS float* s = scr + (8 * c) * 33 + n;
        u32x4 o; o.x = cvt_pk_bf16(s[0 * 33], s[1 * 33]); o.y = cvt_pk_bf16(s[2 * 33], s[3 * 33]); o.z = cvt_pk_bf16(s[4 * 33], s[5 * 33]); o.w = cvt_pk_bf16(s[6 * 33], s[7 * 33]);
        *(u32x4*)(WT + (size_t)(n0 + n) * K + k0 + 8 * c) = o; }
    LDS_WAIT();
}

__device__ __forceinline__ void ssm_tables(const Args& a, int q, int lane) {
    const float* lam_re = a.in[10]; const float* lam_im = a.in[11]; const float* log_dt = a.in[12];
    const float* b_re = a.in[13]; const float* b_im = a.in[14]; const float* c_re = a.in[15]; const float* c_im = a.in[16];
    f32x4* LAMB = (f32x4*)(a.ws + OFF_LAMB); u32x4* BFR = (u32x4*)(a.ws + OFF_BFR); u32x4* CFR = (u32x4*)(a.ws + OFF_CFR);
    const float lr = lam_re[q * 64 + lane], li = lam_im[q * 64 + lane];
    const float dt = expf(log_dt[q]);
    const float er = expf(lr * dt);
    float sn, cs; sincosf(li * dt, &sn, &cs);
    const float are = er * cs, aim = er * sn;
    float pr = are, pi = aim;
#pragma unroll
    for (int i = 0; i < 6; ++i) { const float nr = pr * pr - pi * pi, ni = 2.f * pr * pi; pr = nr; pi = ni; }
    LAMB[q * 64 + lane] = (f32x4){are, aim, pr, pi};
    const float den = lr * lr + li * li;
    const float cr = ((are - 1.f) * lr + aim * li) / den, ci = (aim * lr - (are - 1.f) * li) / den;
    const int i0 = 8 * ((lane >> 4) & 1), lo = lane >> 5;
#pragma unroll
    for (int nt = 0; nt < 8; ++nt) {
        const int n = 16 * nt + (lane & 15), pp = n & 63, part = n >> 6;
        const float crp = __shfl(cr, pp), cip = __shfl(ci, pp);
        const float* br = b_re + ((size_t)q * 64 + pp) * 16 + i0; const float* bi = b_im + ((size_t)q * 64 + pp) * 16 + i0;
        float v[8];
#pragma unroll
        for (int j = 0; j < 8; ++j) { const float x = part == 0 ? (crp * br[j] - cip * bi[j]) : (crp * bi[j] + cip * br[j]);
            const float hi = __uint_as_float(cvt_pk_bf16(x, 0.f) << 16);
            v[j] = lo ? (x - hi) : x; }
        u32x4 o; o.x = cvt_pk_bf16(v[0], v[1]); o.y = cvt_pk_bf16(v[2], v[3]); o.z = cvt_pk_bf16(v[4], v[5]); o.w = cvt_pk_bf16(v[6], v[7]);
        BFR[(q * 8 + nt) * 64 + lane] = o;
    }
#pragma unroll
    for (int ks = 0; ks < 4; ++ks) {
        const int i = lane & 15, pbase = 32 * (ks & 1) + 8 * (lane >> 4), part = ks >> 1;
        const float* src = (part == 0 ? c_re : c_im) + ((size_t)q * 16 + i) * 64 + pbase;
        const float sg = part == 0 ? 1.f : -1.f;
        u32x4 o; o.x = cvt_pk_bf16(sg * src[0], sg * src[1]); o.y = cvt_pk_bf16(sg * src[2], sg * src[3]); o.z = cvt_pk_bf16(sg * src[4], sg * src[5]); o.w = cvt_pk_bf16(sg * src[6], sg * src[7]);
        CFR[(q * 4 + ks) * 64 + lane] = o;
    }
}

__device__ __forceinline__ void adaln_item(const Args& a, int it, LAS float* cact, int tid, int wave, int lane) {
    const int l = it / 96, cc = it % 96;
    const float* c = a.in[1]; const float* cctx = a.in[3]; const float* b_ada = a.in[5];
    float* MOD = (float*)(a.ws + OFF_MOD);
    for (int idx = tid; idx < 33 * 1024; idx += 512) { const int b = idx >> 10, k = idx & 1023; const float v = b < 32 ? c[b * 1024 + k] : cctx[k]; cact[idx] = v / (1.f + expf(-v)); }
    __syncthreads();
    const float* W = a.in[4] + (size_t)l * 1024 * 6144 + cc * 64 + lane;
    float acc[33];
#pragma unroll
    for (int b = 0; b < 33; ++b) acc[b] = 0.f;
    const int kbase = wave * 128;
#pragma unroll 2
    for (int k4 = 0; k4 < 32; ++k4) { const int k = kbase + 4 * k4;
        const float w0 = __builtin_nontemporal_load(W + (size_t)(k + 0) * 6144), w1 = __builtin_nontemporal_load(W + (size_t)(k + 1) * 6144), w2 = __builtin_nontemporal_load(W + (size_t)(k + 2) * 6144), w3 = __builtin_nontemporal_load(W + (size_t)(k + 3) * 6144);
#pragma unroll
        for (int b = 0; b < 33; ++b) { const f32x4 cv = *(const LAS f32x4*)(cact + b * 1024 + k); acc[b] += cv.x * w0 + cv.y * w1 + cv.z * w2 + cv.w * w3; } }
    __syncthreads();
    LAS float* red = cact;
#pragma unroll
    for (int b = 0; b < 33; ++b) red[(wave * 33 + b) * 64 + lane] = acc[b];
    __syncthreads();
    for (int idx = tid; idx < 33 * 64; idx += 512) { const int b = idx >> 6, ln = idx & 63; float s = 0.f;
#pragma unroll
        for (int w = 0; w < 8; ++w) s += red[(w * 33 + b) * 64 + ln];
        MOD[(size_t)(l * 33 + b) * 6144 + cc * 64 + ln] = s + b_ada[l * 6144 + cc * 64 + ln]; }
    __syncthreads();
}

__device__ __forceinline__ void phase_prep(const Args& a, LAS unsigned char* lds, int tid, int wave, int lane) {
    const int G = gridDim.x, gw = blockIdx.x * 8 + wave, NGW = G * 8;
    for (int q = gw; q < 128; q += NGW) ssm_tables(a, q, lane);
    if (blockIdx.x == G - 1) { float* rc = (float*)(a.ws + OFF_ROPE); float* rs = rc + 1024;
        for (int idx = tid; idx < 1024; idx += 512) { const int pidx = idx >> 4, i = idx & 15; const float fr = powf(10000.f, -(float)i / 16.f); float s, c; sincosf((float)pidx * fr, &s, &c); rc[idx] = c; rs[idx] = s; } }
    LAS float* scr = (LAS float*)(lds + wave * 8448);
    constexpr int I_IN = 16 * 56, I_OUT = 16 * 32, I_1 = 16 * 128, I_2 = 64 * 32, I_G = 4 * 8, I_L = I_IN + I_OUT + I_1 + I_2 + I_G;
    for (int it = gw; it < DEPTH * I_L; it += NGW) {
        const int l = it / I_L; int r = it % I_L;
        if (r < I_IN) { transpose_item(a.in[7] + (size_t)l * 1024 * 1792, 1024, 1792, (bf16_t*)(a.ws + OFF_WIN) + (size_t)l * 1792 * 1024, scr, r, lane); continue; } r -= I_IN;
        if (r < I_OUT) { transpose_item(a.in[20] + (size_t)l * 1024 * 1024, 1024, 1024, (bf16_t*)(a.ws + OFF_WOUT) + (size_t)l * 1024 * 1024, scr, r, lane); continue; } r -= I_OUT;
        if (r < I_1) { transpose_item(a.in[21] + (size_t)l * 1024 * 4096, 1024, 4096, (bf16_t*)(a.ws + OFF_W1) + (size_t)l * 4096 * 1024, scr, r, lane); continue; } r -= I_1;
        if (r < I_2) { transpose_item(a.in[22] + (size_t)l * 4096 * 1024, 4096, 1024, (bf16_t*)(a.ws + OFF_W2) + (size_t)l * 1024 * 4096, scr, r, lane); continue; } r -= I_2;
        transpose_item(a.in[18] + (size_t)l * 256 * 256, 256, 256, (bf16_t*)(a.ws + OFF_WGLU) + (size_t)l * 256 * 256, scr, r, lane);
    }
    __syncthreads();
    for (int it = blockIdx.x; it < 4 * 96; it += G) adaln_item(a, it, (LAS float*)lds, tid, wave, lane);
}

typedef _Float16 f16x4 __attribute__((ext_vector_type(4)));
__device__ __forceinline__ unsigned char* h16_row(const Args& a, int r0, bool isctx, bool hop) {
    if (isctx) return a.ws + OFF_HC + (size_t)(r0 - TLAT) * 2048;
    if (!hop) return (unsigned char*)a.out + (size_t)r0 * 2048;
    if (r0 < 41984) return a.ws + OFF_Z + (size_t)536870912 + (size_t)r0 * 2048;
    if (r0 < 58368) return a.ws + OFF_HC + (size_t)(r0 - 41984) * 2048;
    return a.ws + OFF_E + (size_t)(r0 - 58368) * 2048;
}
template <int MODE>
__device__ __forceinline__ void row_pass(const Args& a, int l, int wave, int lane) {
    const int gw = blockIdx.x * 8 + wave, NGW = gridDim.x * 8;
    const float* normg = a.in[6];
    const float* MOD = (const float*)(a.ws + OFF_MOD);
    bf16_t* Abuf = (bf16_t*)(a.ws + OFF_A); const bf16_t* MBuf = (const bf16_t*)(a.ws + OFF_MB);
    const int nrows = (MODE == 0 || l < 3) ? TALL : TLAT;
    const int ntask = nrows >> 3;
    const bool do_a = (MODE != 2) || (l < 3);
    const bool in_f32 = (MODE == 0) || (MODE == 1 && l == 0);
    const bool out_f32 = (MODE == 2 && l == 3);
    for (int task = gw; task < ntask; task += NGW) {
        const int r0 = task << 3;
        const bool isctx = r0 >= TLAT;
        const int b = isctx ? 32 : (r0 >> 11);
        const float* mod = MOD + (size_t)(l * 33 + b) * 6144;
        f32x4 V[4], SA[4], SB[4];
#pragma unroll
        for (int j = 0; j < 4; ++j) { const int col = 4 * lane + 256 * j;
            V[j] = (f32x4){0.f, 0.f, 0.f, 0.f}; SA[j] = V[j]; SB[j] = V[j];
            if (MODE == 0) { SA[j] = *(const f32x4*)(normg + col) * (*(const f32x4*)(mod + 1024 + col) + 1.f); SB[j] = *(const f32x4*)(mod + col); }
            if (MODE == 1) { V[j] = *(const f32x4*)(mod + 2048 + col) * *(const f32x4*)(normg + (l * 4 + 1) * 1024 + col);
                SA[j] = *(const f32x4*)(normg + (l * 4 + 2) * 1024 + col) * (*(const f32x4*)(mod + 4096 + col) + 1.f); SB[j] = *(const f32x4*)(mod + 3072 + col); }
            if (MODE == 2) { V[j] = *(const f32x4*)(mod + 5120 + col) * *(const f32x4*)(normg + (l * 4 + 3) * 1024 + col);
                if (l < 3) { const float* mod2 = MOD + (size_t)((l + 1) * 33 + b) * 6144;
                    SA[j] = *(const f32x4*)(normg + ((l + 1) * 4 + 0) * 1024 + col) * (*(const f32x4*)(mod2 + 1024 + col) + 1.f); SB[j] = *(const f32x4*)(mod2 + col); } }
        }
        const unsigned char* hin0; unsigned char* hout0;
        if (in_f32) hin0 = (const unsigned char*)(isctx ? a.in[2] + (size_t)(r0 - TLAT) * 1024 : a.in[0] + (size_t)r0 * 1024);
        else hin0 = h16_row(a, r0, isctx, MODE == 2 && l == 3);
        if (out_f32) hout0 = (unsigned char*)(a.out + (size_t)r0 * 1024);
        else hout0 = h16_row(a, r0, isctx, MODE == 1 && l == 3);
        const size_t pin = in_f32 ? 4096 : 2048, pout = out_f32 ? 4096 : 2048;
        const bf16_t* mrow0 = MBuf + (size_t)r0 * 1024;
        u32x4 hq[4][4]; u32x2 mq[4][4];
#define RP_LOAD(slot, rr_) do { const unsigned char* hin_ = hin0 + (size_t)(rr_) * pin; \
        _Pragma("unroll") for (int j = 0; j < 4; ++j) { \
            if (in_f32) hq[slot][j] = __builtin_nontemporal_load((const u32x4*)(hin_ + 16 * lane + 1024 * j)); \
            else { const u32x2 t_ = __builtin_nontemporal_load((const u32x2*)(hin_ + 8 * lane + 512 * j)); hq[slot][j] = (u32x4){t_.x, t_.y, 0u, 0u}; } \
            if (MODE != 0) mq[slot][j] = __builtin_nontemporal_load((const u32x2*)(mrow0 + (size_t)(rr_) * 1024 + 4 * lane + 256 * j)); } } while (0)
        RP_LOAD(0, 0); RP_LOAD(1, 1); RP_LOAD(2, 2); RP_LOAD(3, 3);
#pragma unroll
        for (int rr = 0; rr < 8; ++rr) {
            const int r = r0 + rr;
            unsigned char* hout = hout0 + (size_t)rr * pout;
            u32x4 hw[4]; u32x2 mw[4];
#pragma unroll
            for (int j = 0; j < 4; ++j) { hw[j] = hq[rr & 3][j]; if (MODE != 0) mw[j] = mq[rr & 3][j]; }
            if (rr + 4 < 8) RP_LOAD(rr & 3, rr + 4);
            f32x4 h[4];
#pragma unroll
            for (int j = 0; j < 4; ++j) {
                if (in_f32) h[j] = __builtin_bit_cast(f32x4, hw[j]);
                else { const u32x2 t = {hw[j].x, hw[j].y}; h[j] = __builtin_convertvector(__builtin_bit_cast(f16x4, t), f32x4); } }
            if (MODE != 0) {
                f32x4 mv[4]; float ss = 0.f;
#pragma unroll
                for (int j = 0; j < 4; ++j) { const u32x2 w = mw[j];
                    mv[j] = (f32x4){bf_lo(w.x), bf_hi(w.x), bf_lo(w.y), bf_hi(w.y)};
                    if (isctx) { const u32x2 w2 = *(const u32x2*)((const bf16_t*)(a.ws + OFF_E) + (size_t)(r - TLAT) * 1024 + 4 * lane + 256 * j);
                        mv[j] = mv[j] + (f32x4){bf_lo(w2.x), bf_hi(w2.x), bf_lo(w2.y), bf_hi(w2.y)}; }
                    ss += mv[j].x * mv[j].x + mv[j].y * mv[j].y + mv[j].z * mv[j].z + mv[j].w * mv[j].w; }
                ss = wave_sum(ss);
                const float rinv = rsqrtf(ss * (1.f / 1024.f) + 1e-6f);
#pragma unroll
                for (int j = 0; j < 4; ++j) { h[j] = h[j] + V[j] * (mv[j] * rinv);
                    if (out_f32) __builtin_nontemporal_store(h[j], (f32x4*)(hout + 16 * lane + 1024 * j));
                    else __builtin_nontemporal_store(__builtin_bit_cast(u32x2, __builtin_convertvector(h[j], f16x4)), (u32x2*)(hout + 8 * lane + 512 * j)); }
            }
            if (do_a) {
                float ss = 0.f;
#pragma unroll
                for (int j = 0; j < 4; ++j) ss += h[j].x * h[j].x + h[j].y * h[j].y + h[j].z * h[j].z + h[j].w * h[j].w;
                ss = wave_sum(ss);
                const float rinv = rsqrtf(ss * (1.f / 1024.f) + 1e-6f);
#pragma unroll
                for (int j = 0; j < 4; ++j) { const f32x4 o = (h[j] * rinv) * SA[j] + SB[j];
                    u32x2 w; w.x = cvt_pk_bf16(o.x, o.y); w.y = cvt_pk_bf16(o.z, o.w);
                    *(u32x2*)(Abuf + (size_t)r * 1024 + 4 * lane + 256 * j) = w; }
            }
        }
#undef RP_LOAD
    }
}

__device__ __forceinline__ void attn_item(const Args& a, int l, int item, LAS unsigned char* lds, int tid, int wave, int lane) {
    const bf16_t* P = (const bf16_t*)(a.ws + OFF_P);
    bf16_t* MIX = (bf16_t*)(a.ws + OFF_MIX);
    int b, kvh, qb; bool latq;
    if (item < 2048) { latq = true; b = item >> 6; kvh = (item >> 5) & 1; qb = item & 31; }
    else { const int it = item - 2048; latq = false; b = it >> 3; kvh = (it >> 2) & 1; qb = it & 3; }
    const int hq = wave >> 1, qhalf = wave & 1, head = kvh * 4 + hq;
    const int qpos0 = qb * 64 + qhalf * 32;
    const size_t seq0 = latq ? (size_t)b * SEQ : (size_t)TLAT + (size_t)b * CTXL;
    const size_t qrow0 = seq0 + qpos0;
    int lat_lo = 0, nlat = 0;
    if (latq) { lat_lo = qb * 64 - 128; if (lat_lo < 0) lat_lo = 0; int lat_hi = qb * 64 + 192; if (lat_hi > SEQ) lat_hi = SEQ; nlat = (lat_hi - lat_lo) >> 6; }
    const int ntiles = nlat + 4;
    const int lr = lane & 31, h = lane >> 5;
    bf16x8 qf[4];
#pragma unroll
    for (int ks = 0; ks < 4; ++ks) qf[ks] = *(const bf16x8*)(P + (qrow0 + lr) * INW + head * 64 + 16 * ks + 8 * h);
    const float sinkv = a.in[9][l * 8 + head] * 1.4426950408889634f;
    float mrun = sinkv, ls = (h == 0 ? 1.f : 0.f);
    f32x16 Y[2];
#pragma unroll
    for (int i = 0; i < 2; ++i)
#pragma unroll
        for (int e = 0; e < 16; ++e) Y[i][e] = 0.f;
    const int kkey = tid >> 3, kdc = tid & 7;
    u32x4 kreg, vreg;
#define ATT_TROW(i) ((i) < nlat ? (size_t)b * SEQ + lat_lo + 64 * (i) : (size_t)TLAT + (size_t)b * CTXL + 64 * ((i) - nlat))
#define ATT_LOAD(i) do { const size_t trow = ATT_TROW(i); \
        kreg = *(const u32x4*)(P + (trow + kkey) * INW + 512 + kvh * 64 + 8 * kdc); \
        vreg = *(const u32x4*)(P + (trow + lane) * INW + 640 + kvh * 64 + 8 * wave); } while (0)
#define ATT_WRITE(buf) do { *(LAS u32x4*)(lds + (buf) * 9216 + kkey * 144 + kdc * 16) = kreg; \
        LAS bf16_t* vt = (LAS bf16_t*)(lds + 18432 + (buf) * 9216) + (8 * wave) * 72 + lane; \
        vt[0 * 72] = (bf16_t)(vreg.x & 0xffffu); vt[1 * 72] = (bf16_t)(vreg.x >> 16); vt[2 * 72] = (bf16_t)(vreg.y & 0xffffu); vt[3 * 72] = (bf16_t)(vreg.y >> 16); \
        vt[4 * 72] = (bf16_t)(vreg.z & 0xffffu); vt[5 * 72] = (bf16_t)(vreg.z >> 16); vt[6 * 72] = (bf16_t)(vreg.w & 0xffffu); vt[7 * 72] = (bf16_t)(vreg.w >> 16); } while (0)
    ATT_LOAD(0); ATT_WRITE(0);
    __syncthreads();
    for (int i = 0; i < ntiles; ++i) {
        if (i + 1 < ntiles) ATT_LOAD(i + 1);
        const bool lat = i < nlat; const int k0 = lat_lo + 64 * i;
        const bool skip = lat && (k0 > qpos0 + 159 || k0 < qpos0 - 191);
        if (!skip) {
            const LAS unsigned char* Kb = lds + (i & 1) * 9216; const LAS unsigned char* Vb = lds + 18432 + (i & 1) * 9216;
            f32x16 X[2];
#pragma unroll
            for (int i2 = 0; i2 < 2; ++i2)
#pragma unroll
                for (int e = 0; e < 16; ++e) X[i2][e] = 0.f;
#pragma unroll
            for (int ks = 0; ks < 4; ++ks) {
                const bf16x8 kf0 = *(const LAS bf16x8*)(Kb + lr * 144 + (16 * ks + 8 * h) * 2);
                const bf16x8 kf1 = *(const LAS bf16x8*)(Kb + (32 + lr) * 144 + (16 * ks + 8 * h) * 2);
                X[0] = MFMA32(kf0, qf[ks], X[0]); X[1] = MFMA32(kf1, qf[ks], X[1]);
            }
            const bool needmask = lat && (k0 > qpos0 + 65 || k0 < qpos0 - 97);
            if (needmask) {
#pragma unroll
                for (int mt = 0; mt < 2; ++mt) { const int base = (k0 + 32 * mt + 4 * h) - (qpos0 + lr);
#pragma unroll
                    for (int e = 0; e < 16; ++e) { const int diff = base + (e & 3) + 8 * (e >> 2); if (diff > 128 || diff < -128) X[mt][e] = -1e30f; } }
            }
            {
                float mx = X[0][0];
#pragma unroll
                for (int e = 1; e < 16; ++e) mx = fmaxf(mx, X[0][e]);
#pragma unroll
                for (int e = 0; e < 16; ++e) mx = fmaxf(mx, X[1][e]);
                mx = fmaxf(mx, __shfl_xor(mx, 32));
                if (__builtin_amdgcn_ballot_w64(mx > mrun) != 0ull) {
                    const float mnew = fmaxf(mrun, mx);
                    const float alpha = __builtin_amdgcn_exp2f(mrun - mnew);
                    mrun = mnew;
                    ls = ls * alpha;
                    Y[0] = Y[0] * alpha; Y[1] = Y[1] * alpha;
                }
                float sum = 0.f;
#pragma unroll
                for (int mt = 0; mt < 2; ++mt)
#pragma unroll
                    for (int e = 0; e < 16; ++e) { const float p = __builtin_amdgcn_exp2f(X[mt][e] - mrun); X[mt][e] = p; sum += p; }
                ls += sum;
            }
#pragma unroll
            for (int mt = 0; mt < 2; ++mt)
#pragma unroll
                for (int s = 0; s < 2; ++s) {
                    u32x4 w; w.x = cvt_pk_bf16(X[mt][8 * s + 0], X[mt][8 * s + 1]); w.y = cvt_pk_bf16(X[mt][8 * s + 2], X[mt][8 * s + 3]);
                    w.z = cvt_pk_bf16(X[mt][8 * s + 4], X[mt][8 * s + 5]); w.w = cvt_pk_bf16(X[mt][8 * s + 6], X[mt][8 * s + 7]);
                    const bf16x8 pf = __builtin_bit_cast(bf16x8, w);
#pragma unroll
                    for (int dt = 0; dt < 2; ++dt) {
                        const LAS unsigned char* vp = Vb + (32 * dt + lr) * 144 + (32 * mt + 16 * s + 4 * h) * 2;
                        const u32x2 v0 = *(const LAS u32x2*)vp, v1 = *(const LAS u32x2*)(vp + 16);
                        const u32x4 vv = {v0.x, v0.y, v1.x, v1.y};
                        const bf16x8 vf = __builtin_bit_cast(bf16x8, vv);
                        Y[dt] = MFMA32(vf, pf, Y[dt]);
                    }
                }
        }
        if (i + 1 < ntiles) ATT_WRITE((i + 1) & 1);
        __syncthreads();
    }
    {
        const float lt = ls + __shfl_xor(ls, 32);
        const float inv = __builtin_amdgcn_rcpf(lt);
        LAS unsigned char* ot = lds + wave * 4608;
#pragma unroll
        for (int dt = 0; dt < 2; ++dt)
#pragma unroll
            for (int rg = 0; rg < 4; ++rg) { u32x2 w; w.x = cvt_pk_bf16(Y[dt][4 * rg + 0] * inv, Y[dt][4 * rg + 1] * inv); w.y = cvt_pk_bf16(Y[dt][4 * rg + 2] * inv, Y[dt][4 * rg + 3] * inv);
                *(LAS u32x2*)(ot + lr * 144 + (32 * dt + 8 * rg + 4 * h) * 2) = w; }
        LDS_WAIT();
#pragma unroll
        for (int k = 0; k < 4; ++k) { const int row = 8 * k + (lane >> 3), ch = lane & 7;
            const u32x4 w = *(const LAS u32x4*)(ot + row * 144 + ch * 16);
            *(u32x4*)(MIX + (qrow0 + row) * 1024 + head * 64 + ch * 8) = w; }
        __syncthreads();
    }
#undef ATT_TROW
#undef ATT_LOAD
#undef ATT_WRITE
}

__device__ __forceinline__ float gelu_tanh(float y) {
    const float u = 0.7978845608028654f * (y + 0.044715f * y * y * y);
    const float t = 1.f - 2.f * __builtin_amdgcn_rcpf(1.f + __expf(2.f * u));
    return 0.5f * y * (1.f + t);
}
__device__ __forceinline__ void ssm_end_item(const Args& a, int l, int item, LAS unsigned char* lds, int tid, int wave, int lane) {
    const bf16_t* P = (const bf16_t*)(a.ws + OFF_P);
    const f32x4* LAMB = (const f32x4*)(a.ws + OFF_LAMB); const u32x4* BFR = (const u32x4*)(a.ws + OFF_BFR);
    const int ql = item >> 3, rb = item & 7, dir = ql >> 4, g = ql & 15, q = (l * 2 + dir) * 16 + g;
    const int fr = lane & 15, kq = lane >> 4, th = kq >> 1, j0 = 8 * (kq & 1);
    const int n = 16 * wave + fr, p = n & 63, part = n >> 6;
    float Br[8], Bi[8];
    { const int ntr = wave & 3, nti = ntr + 4, ln = fr + 16 * (kq & 1);
      const u32x4 rh = BFR[(q * 8 + ntr) * 64 + ln], rl = BFR[(q * 8 + ntr) * 64 + ln + 32], ih = BFR[(q * 8 + nti) * 64 + ln], il = BFR[(q * 8 + nti) * 64 + ln + 32];
#pragma unroll
      for (int d = 0; d < 4; ++d) { Br[2 * d] = bf_lo(rh[d]) + bf_lo(rl[d]); Br[2 * d + 1] = bf_hi(rh[d]) + bf_hi(rl[d]);
                                    Bi[2 * d] = bf_lo(ih[d]) + bf_lo(il[d]); Bi[2 * d + 1] = bf_hi(ih[d]) + bf_hi(il[d]); } }
    const f32x4 lam = LAMB[q * 64 + p];
    const float l2r = lam.x * lam.x - lam.y * lam.y, l2i = 2.f * lam.x * lam.y;
    const bool e1 = dir ? (th == 1) : (th == 0);
    float wr = e1 ? lam.x : 1.f, wi = e1 ? lam.y : 0.f;
    f32x4 acc[9];
#pragma unroll
    for (int m = 0; m < 9; ++m) acc[m] = (f32x4){0.f, 0.f, 0.f, 0.f};
    const int rbase = 144 * rb;
    unsigned go[9];
#pragma unroll
    for (int k = 0; k < 9; ++k) { const int idx = tid + 512 * k, row = idx >> 5, pc = idx & 31, r = rbase + row, b = r / 36, ci = r - 36 * b;
        const unsigned row0 = ci < 4 ? (unsigned)(TLAT + b * CTXL + 64 * ci) : (unsigned)(b * SEQ + 64 * (ci - 4));
        go[k] = (row0 + (unsigned)(pc >> 1)) * (unsigned)INW + 1536u + 16u * g + 8u * (pc & 1); }
    u32x4 st[9];
#define SE_LOADQ(kh_) do { const unsigned tb_ = (unsigned)((dir ? 16 * (kh_) : 48 - 16 * (kh_)) * INW); \
        _Pragma("unroll") for (int k = 0; k < 9; ++k) st[k] = *(const u32x4*)(P + (size_t)(go[k] + tb_)); } while (0)
    SE_LOADQ(0);
#pragma unroll 1
    for (int kh = 0; kh < 4; ++kh) {
        bf16x8 bq[8];
#pragma unroll
        for (int i = 0; i < 8; ++i) {
            float v[8];
#pragma unroll
            for (int jj = 0; jj < 8; ++jj) v[jj] = part == 0 ? (wr * Br[jj] - wi * Bi[jj]) : (wr * Bi[jj] + wi * Br[jj]);
            u32x4 o; o.x = cvt_pk_bf16(v[0], v[1]); o.y = cvt_pk_bf16(v[2], v[3]); o.z = cvt_pk_bf16(v[4], v[5]); o.w = cvt_pk_bf16(v[6], v[7]);
            bq[i] = __builtin_bit_cast(bf16x8, o);
            const float nr = wr * l2r - wi * l2i, ni = wr * l2i + wi * l2r; wr = nr; wi = ni;
        }
        __syncthreads();
#pragma unroll
        for (int k = 0; k < 9; ++k) { const int idx = tid + 512 * k; *(LAS u32x4*)(lds + (idx >> 5) * 528 + (idx & 31) * 16) = st[k]; }
        __syncthreads();
        if (kh < 3) SE_LOADQ(kh + 1);
        const LAS unsigned char* ab = lds + fr * 528 + (dir ? th : 14 + th) * 32 + j0 * 2;
        const int tstep = dir ? 64 : -64;
#pragma unroll
        for (int mt = 0; mt < 9; ++mt) {
            bf16x8 af[8];
#pragma unroll
            for (int i = 0; i < 8; ++i) af[i] = *(const LAS bf16x8*)(ab + mt * (16 * 528) + i * tstep);
#pragma unroll
            for (int i = 0; i < 8; ++i) acc[mt] = MFMA16(af[i], bq[i], acc[mt]);
            __builtin_amdgcn_sched_barrier(0);
        }
    }
#undef SE_LOADQ
    __syncthreads();
    {
        LAS float* El = (LAS float*)lds;
#pragma unroll
        for (int mt = 0; mt < 9; ++mt)
#pragma unroll
            for (int rg = 0; rg < 4; ++rg) El[(16 * mt + 4 * kq + rg) * 132 + n] = acc[mt][rg];
        __syncthreads();
        if (tid < 256) {
            const int bl = tid >> 6, pp = tid & 63, b = 4 * rb + bl;
            const f32x4 lm = LAMB[q * 64 + pp];
            f32x2* E2p = (f32x2*)(a.ws + OFF_E2) + ((size_t)((b * 2 + dir) * 36) * 16 + g) * 64 + pp;
            float hr = 0.f, hi = 0.f;
#pragma unroll 4
            for (int cd = 0; cd < 36; ++cd) {
                const int ci = dir ? (cd < 4 ? 3 - cd : 39 - cd) : cd;
                const float er = El[(bl * 36 + ci) * 132 + pp], ei = El[(bl * 36 + ci) * 132 + 64 + pp];
                E2p[(size_t)cd * 1024] = (f32x2){hr, hi};
                const float nr = lm.z * hr - lm.w * hi + er, ni = lm.z * hi + lm.w * hr + ei; hr = nr; hi = ni;
            }
        }
    }
}

__device__ __forceinline__ void carry_scan(const Args& a, int l, int wave, int lane) {
    const int gw = blockIdx.x * 8 + wave, NGW = gridDim.x * 8;
    const f32x4* LAMB = (const f32x4*)(a.ws + OFF_LAMB);
    const f32x2* E = (const f32x2*)(a.ws + OFF_E); f32x2* E2 = (f32x2*)(a.ws + OFF_E2);
    for (int task = gw; task < 1024; task += NGW) {
        const int b = task >> 5, dir = (task >> 4) & 1, g = task & 15;
        const f32x4 lam = LAMB[((l * 2 + dir) * 16 + g) * 64 + lane];
        const f32x2* Ep = E + ((size_t)((b * 2 + dir) * 36) * 16 + g) * 64 + lane;
        f32x2* Eq = E2 + ((size_t)((b * 2 + dir) * 36) * 16 + g) * 64 + lane;
        float hre = 0.f, him = 0.f;
#pragma unroll 1
        for (int c0 = 0; c0 < 36; c0 += 12) {
            f32x2 e[12];
#pragma unroll
            for (int i = 0; i < 12; ++i) e[i] = Ep[(size_t)(c0 + i) * 1024];
#pragma unroll
            for (int i = 0; i < 12; ++i) { Eq[(size_t)(c0 + i) * 1024] = (f32x2){hre, him};
                const float nre = lam.z * hre - lam.w * him + e[i].x, nim = lam.z * him + lam.w * hre + e[i].y; hre = nre; him = nim; }
        }
    }
}

template <bool PASS2>
__device__ __forceinline__ void ssm_item(const Args& a, int l, int b, int ci, LAS unsigned char* lds, int tid, int wave, int lane) {
    const bf16_t* P = (const bf16_t*)(a.ws + OFF_P);
    bf16_t* MIX = (bf16_t*)(a.ws + OFF_MIX);
    const f32x4* LAMB = (const f32x4*)(a.ws + OFF_LAMB); const bf16x8* BFR = (const bf16x8*)(a.ws + OFF_BFR); const bf16x8* CFR = (const bf16x8*)(a.ws + OFF_CFR);
    f32x2* E = (f32x2*)(a.ws + OFF_E); const f32x2* E2 = (const f32x2*)(a.ws + OFF_E2);
    const bool isctx = ci < 4; const int j = isctx ? ci : ci - 4;
    const size_t row0 = isctx ? (size_t)TLAT + (size_t)b * CTXL + 64 * j : (size_t)b * SEQ + 64 * j;
    const int cf = isctx ? j : 4 + j, cbk = isctx ? 3 - j : 35 - j;
    LAS bf16_t* U = (LAS bf16_t*)lds;
    LAS float* Dw = (LAS float*)(lds + 33792 + wave * 8448);
    LAS bf16_t* Hw = (LAS bf16_t*)(lds + 101376 + wave * 4352);
    f32x4 lamN; f32x2 hinN = {0.f, 0.f}; bf16x8 bfrN[8], cfrN[4];
#define SSM_FETCH(tk) do { const int g_ = 2 * wave + ((tk) >> 1), dir_ = (tk) & 1, q_ = (l * 2 + dir_) * 16 + g_; \
        lamN = LAMB[q_ * 64 + lane]; \
        if (PASS2) hinN = E2[((size_t)((b * 2 + dir_) * 36 + (dir_ ? cbk : cf)) * 16 + g_) * 64 + lane]; \
        _Pragma("unroll") for (int nt = 0; nt < 8; ++nt) bfrN[nt] = BFR[(q_ * 8 + nt) * 64 + lane]; \
        if (PASS2) { _Pragma("unroll") for (int ks = 0; ks < 4; ++ks) cfrN[ks] = CFR[(q_ * 4 + ks) * 64 + lane]; } } while (0)
    SSM_FETCH(0);
#pragma unroll
    for (int i = 0; i < 4; ++i) { const int piece = tid + 512 * i, t = piece >> 5, c16 = piece & 31;
        *(LAS u32x4*)(U + t * 264 + 8 * c16) = *(const u32x4*)(P + (row0 + t) * INW + 1536 + 8 * c16); }
    __syncthreads();
    const int fr = lane & 15, fq = lane >> 4;
    f32x4 acc[4];
#pragma unroll 1
    for (int tk = 0; tk < 4; ++tk) {
        const int g = 2 * wave + (tk >> 1), dir = tk & 1;
        const f32x4 lam = lamN; const float are = lam.x, aim = lam.y, naim = -lam.y;
        float hre = hinN.x, him = hinN.y;
        bf16x8 bfr[8], cfr[4];
#pragma unroll
        for (int nt = 0; nt < 8; ++nt) bfr[nt] = bfrN[nt];
#pragma unroll
        for (int ks = 0; ks < 4; ++ks) cfr[ks] = cfrN[ks];
        if (tk < 3) SSM_FETCH(tk + 1);
        if (dir == 0) {
#pragma unroll
            for (int m = 0; m < 4; ++m) acc[m] = (f32x4){0.f, 0.f, 0.f, 0.f}; }
#pragma unroll 1
        for (int sb = 0; sb < 4; ++sb) {
            const int mt = dir ? 3 - sb : sb;
            const bf16x8 uf = *(const LAS bf16x8*)(U + (16 * mt + fr) * 264 + 16 * g + 8 * (fq & 1));
#pragma unroll
            for (int nt = 0; nt < 8; ++nt) { const f32x4 d = MFMA16(uf, bfr[nt], ((f32x4){0.f, 0.f, 0.f, 0.f}));
#pragma unroll
                for (int r = 0; r < 4; ++r) Dw[(4 * fq + r) * 132 + 16 * nt + fr] = d[r]; }
            LDS_WAIT();
            float dr[16], di[16];
#pragma unroll
            for (int s = 0; s < 8; ++s) { const int t = dir ? 15 - s : s; dr[s] = Dw[t * 132 + lane]; di[s] = Dw[t * 132 + 64 + lane]; }
            LDS_WAIT();
#pragma unroll
            for (int s = 8; s < 16; ++s) { const int t = dir ? 15 - s : s; dr[s] = Dw[t * 132 + lane]; di[s] = Dw[t * 132 + 64 + lane]; }
            LDS_WAIT();
#pragma unroll
            for (int s = 0; s < 16; ++s) {
                float t1, t2, nre, nim;
                asm("v_fma_f32 %0, %1, %2, %3" : "=v"(t1) : "v"(naim), "v"(him), "v"(dr[s]));
                asm("v_fma_f32 %0, %1, %2, %3" : "=v"(t2) : "v"(aim), "v"(hre), "v"(di[s]));
                asm("v_fma_f32 %0, %1, %2, %3" : "=v"(nre) : "v"(are), "v"(hre), "v"(t1));
                asm("v_fma_f32 %0, %1, %2, %3" : "=v"(nim) : "v"(are), "v"(him), "v"(t2));
                hre = nre; him = nim;
                dr[s] = hre; di[s] = him; }
            if (PASS2) {
                unsigned pk[16];
#pragma unroll
                for (int s = 0; s < 16; ++s) pk[s] = cvt_pk_bf16(dr[s], di[s]);
#pragma unroll
                for (int s = 0; s < 16; ++s) { const int t = dir ? 15 - s : s;
                    Hw[t * 136 + lane] = (bf16_t)(pk[s] & 0xffffu); Hw[t * 136 + 64 + lane] = (bf16_t)(pk[s] >> 16);
                    if ((s & 3) == 3) LDS_WAIT(); }
            }
            LDS_WAIT();
            if (PASS2) {
                f32x4 am = acc[0];
                if (mt == 1) am = acc[1]; if (mt == 2) am = acc[2]; if (mt == 3) am = acc[3];
#pragma unroll
                for (int ks = 0; ks < 4; ++ks) { const bf16x8 hf = *(const LAS bf16x8*)(Hw + fr * 136 + 32 * ks + 8 * fq); am = MFMA16(hf, cfr[ks], am); }
                if (mt == 0) acc[0] = am; if (mt == 1) acc[1] = am; if (mt == 2) acc[2] = am; if (mt == 3) acc[3] = am;
                LDS_WAIT();
            }
        }
        if (!PASS2) E[((size_t)((b * 2 + dir) * 36 + (dir ? cbk : cf)) * 16 + g) * 64 + lane] = (f32x2){hre, him};
        if (PASS2 && dir == 1) {
            const int ch = 16 * g + fr; const float dsk = a.in[17][l * 256 + ch];
#pragma unroll
            for (int mt = 0; mt < 4; ++mt)
#pragma unroll
                for (int r = 0; r < 4; ++r) { const int t = 16 * mt + 4 * fq + r; const float u = bf2f(U[t * 264 + ch]);
                    const float y = acc[mt][r] + dsk * u; const float gl = gelu_tanh(y);
                    U[t * 264 + ch] = (bf16_t)(cvt_pk_bf16(gl, 0.f) & 0xffffu); }
        }
    }
#undef SSM_FETCH
    if (PASS2) {
        __syncthreads();
        const bf16_t* WG = (const bf16_t*)(a.ws + OFF_WGLU) + (size_t)l * 65536;
        f32x4 ga[4][2];
#pragma unroll
        for (int m = 0; m < 4; ++m)
#pragma unroll
            for (int n = 0; n < 2; ++n) ga[m][n] = (f32x4){0.f, 0.f, 0.f, 0.f};
        bf16x8 bw[8][2];
#pragma unroll
        for (int ks = 0; ks < 8; ++ks)
#pragma unroll
            for (int nt = 0; nt < 2; ++nt) bw[ks][nt] = *(const bf16x8*)(WG + (size_t)(32 * wave + 16 * nt + fr) * 256 + 32 * ks + 8 * fq);
#pragma unroll
        for (int ks = 0; ks < 8; ++ks) {
#pragma unroll
            for (int mt = 0; mt < 4; ++mt) { const bf16x8 af = *(const LAS bf16x8*)(U + (16 * mt + fr) * 264 + 32 * ks + 8 * fq);
                ga[mt][0] = MFMA16(af, bw[ks][0], ga[mt][0]); ga[mt][1] = MFMA16(af, bw[ks][1], ga[mt][1]); }
        }
#pragma unroll
        for (int nt = 0; nt < 2; ++nt) { const int n = 32 * wave + 16 * nt + fr; const float bg = a.in[19][l * 256 + n];
#pragma unroll
            for (int mt = 0; mt < 4; ++mt)
#pragma unroll
                for (int r = 0; r < 4; ++r) { const int t = 16 * mt + 4 * fq + r; const float gv = bf2f(U[t * 264 + n]);
                    const float z = ga[mt][nt][r] + bg; const float o = gv * __builtin_amdgcn_rcpf(1.f + __expf(-z));
                    MIX[(row0 + t) * 1024 + 768 + n] = (bf16_t)(cvt_pk_bf16(o, 0.f) & 0xffffu); } }
    }
    __syncthreads();
}

__device__ __forceinline__ void conv_phase(const Args& a, int l, int tid) {
    const bf16_t* P = (const bf16_t*)(a.ws + OFF_P);
    bf16_t* MIX = (bf16_t*)(a.ws + OFF_MIX);
    const float* cw = a.in[8] + l * 768;
    const int nrows = l < 3 ? TALL : TLAT;
    const int total = (nrows >> 2) * 32;
    for (int idx = blockIdx.x * 512 + tid; idx < total; idx += gridDim.x * 512) {
        const int r4 = (idx >> 5) * 4, c8 = (idx & 31) * 8;
        const int pos0 = r4 < TLAT ? (r4 & 2047) : ((r4 - TLAT) & 255);
        const int seqlen = r4 < TLAT ? SEQ : CTXL;
        const bool has_prev = pos0 != 0, has_next = (pos0 + 4) != seqlen;
        const bf16_t* pr = P + (size_t)r4 * INW + c8;
        u32x4 cc[6], cx[6], cb[4];
#pragma unroll
        for (int k = 0; k < 6; ++k) { cc[k] = (u32x4){0, 0, 0, 0}; cx[k] = cc[k]; }
        if (has_prev) { cc[0] = *(const u32x4*)(pr - INW + 1024); cx[0] = *(const u32x4*)(pr - INW + 1280); }
#pragma unroll
        for (int k = 1; k < 5; ++k) { cc[k] = *(const u32x4*)(pr + (size_t)(k - 1) * INW + 1024); cx[k] = *(const u32x4*)(pr + (size_t)(k - 1) * INW + 1280); cb[k - 1] = *(const u32x4*)(pr + (size_t)(k - 1) * INW + 768); }
        if (has_next) { cc[5] = *(const u32x4*)(pr + (size_t)4 * INW + 1024); cx[5] = *(const u32x4*)(pr + (size_t)4 * INW + 1280); }
        float w0[8], w1[8], w2[8];
#pragma unroll
        for (int d = 0; d < 8; ++d) { w0[d] = cw[c8 + d]; w1[d] = cw[256 + c8 + d]; w2[d] = cw[512 + c8 + d]; }
        float e[6][8];
#pragma unroll
        for (int k = 0; k < 6; ++k)
#pragma unroll
            for (int d = 0; d < 4; ++d) { e[k][2 * d] = bf_lo(cc[k][d]) * bf_lo(cx[k][d]); e[k][2 * d + 1] = bf_hi(cc[k][d]) * bf_hi(cx[k][d]); }
#pragma unroll
        for (int i = 0; i < 4; ++i) {
            float o[8];
#pragma unroll
            for (int d = 0; d < 4; ++d) {
                o[2 * d]     = bf_lo(cb[i][d]) * (w0[2 * d] * e[i][2 * d] + w1[2 * d] * e[i + 1][2 * d] + w2[2 * d] * e[i + 2][2 * d]);
                o[2 * d + 1] = bf_hi(cb[i][d]) * (w0[2 * d + 1] * e[i][2 * d + 1] + w1[2 * d + 1] * e[i + 1][2 * d + 1] + w2[2 * d + 1] * e[i + 2][2 * d + 1]);
            }
            u32x4 w; w.x = cvt_pk_bf16(o[0], o[1]); w.y = cvt_pk_bf16(o[2], o[3]); w.z = cvt_pk_bf16(o[4], o[5]); w.w = cvt_pk_bf16(o[6], o[7]);
            *(u32x4*)(MIX + (size_t)(r4 + i) * 1024 + 512 + c8) = w;
        }
    }
}

#define XB_TMO      128
#define XB_XCNT(j)  (256  + 64 * (j))
#define XB_XSUB(j)  (1280 + 64 * (j))
#define XB_XGEN(j)  (2304 + 64 * (j))
#define XB_TOP      3328
#define XB_TOPGEN   3392
#define XCD_BAR_WORDS 3456
#define XB_SPIN_CAP (1u << 18)
__device__ __forceinline__ unsigned xb_ld(unsigned* p)              { return __hip_atomic_load(p, __ATOMIC_RELAXED, __HIP_MEMORY_SCOPE_AGENT); }
__device__ __forceinline__ unsigned xb_add(unsigned* p, unsigned v) { return __hip_atomic_fetch_add(p, v, __ATOMIC_RELAXED, __HIP_MEMORY_SCOPE_AGENT); }
__device__ __forceinline__ unsigned xb_xcc_id() { return (unsigned)__builtin_amdgcn_s_getreg((3 << 11) | 20) & 0xFu; }
#define XB_SPIN(cond, bar) do { unsigned _sp = 0; while (cond) { __builtin_amdgcn_s_sleep(1); \
    if ((++_sp & 255u) == 0u) { if (xb_ld(&(bar)[XB_TMO])) break; if (_sp > XB_SPIN_CAP) { atomicAdd(&(bar)[XB_TMO], 1u); break; } } } } while (0)
struct XcdBarrier { unsigned* bar; unsigned x; volatile LAS unsigned* st; };
__device__ __forceinline__ XcdBarrier xcd_barrier_post(unsigned* bar, volatile LAS unsigned* st) {
    XcdBarrier b; b.bar = bar; b.x = xb_xcc_id(); b.st = st;
    if (threadIdx.x == 0) (void)xb_add(&bar[XB_XCNT(b.x)], 1u);
    return b;
}
__device__ __forceinline__ void xcd_barrier_complete(unsigned* bar, unsigned x, unsigned& nloc, unsigned& nx) {
    const unsigned G = gridDim.x * gridDim.y * gridDim.z;
    unsigned sum, cnt, mine, sp = 0u;
    for (;;) {
        sum = 0u; cnt = 0u; mine = 0u;
#pragma unroll
        for (unsigned j = 0; j < 16; ++j) { const unsigned c = xb_ld(&bar[XB_XCNT(j)]); sum += c; cnt += (c > 0u) ? 1u : 0u; mine = (j == x) ? c : mine; }
        if (sum == G) break;
        __builtin_amdgcn_s_sleep(1);
        if ((++sp & 255u) == 0u) { if (xb_ld(&bar[XB_TMO])) break; if (sp > XB_SPIN_CAP) { atomicAdd(&bar[XB_TMO], 1u); break; } }
    }
    nloc = mine > 0u ? mine : 1u; nx = cnt > 0u ? cnt : 1u;
}
__device__ __forceinline__ void xcd_barrier(const XcdBarrier& b) {
    asm volatile("s_waitcnt vmcnt(0)" ::: "memory");
    __syncthreads();
    if (threadIdx.x == 0) {
        unsigned* bar = b.bar;
        __builtin_amdgcn_s_waitcnt(0);
        unsigned nloc = b.st[0], nx = b.st[1];
        if (nloc == 0u) { xcd_barrier_complete(bar, b.x, nloc, nx); b.st[0] = nloc; b.st[1] = nx; }
        const unsigned old = xb_add(&bar[XB_XSUB(b.x)], 1u);
        const unsigned gen = old / nloc;
        if (old + 1u == (gen + 1u) * nloc) {
            __builtin_amdgcn_fence(__ATOMIC_RELEASE, "agent");
            asm volatile("s_waitcnt vmcnt(0)" ::: "memory");
            const unsigned og = xb_add(&bar[XB_TOP], 1u);
            const unsigned tg = og / nx;
            if (og + 1u == (tg + 1u) * nx) xb_add(&bar[XB_TOPGEN], 1u);
            else XB_SPIN(xb_ld(&bar[XB_TOPGEN]) == tg, bar);
            __builtin_amdgcn_fence(__ATOMIC_ACQUIRE, "agent");
            xb_add(&bar[XB_XGEN(b.x)], 1u);
            asm volatile("s_waitcnt vmcnt(0)" ::: "memory");
        } else {
            XB_SPIN(xb_ld(&bar[XB_XGEN(b.x)]) == gen, bar);
            __builtin_amdgcn_fence(__ATOMIC_ACQUIRE, "agent");
            asm volatile("s_waitcnt vmcnt(0)" ::: "memory");
        }
    }
    __syncthreads();
}

__global__ void __launch_bounds__(512) mk_fwd(Args a) {
    extern __shared__ __attribute__((aligned(16))) unsigned char smem[];
    LAS unsigned char* lds = (LAS unsigned char*)smem;
    cg::grid_group grid = cg::this_grid();
    const int G = gridDim.x;
#define FRESH() const int tid = fresh_tid(); const int lane = tid & 63; const int wave = __builtin_amdgcn_readfirstlane(tid >> 6); (void)tid; (void)lane; (void)wave
    const int lo = a.ph_lo, hi = a.ph_hi;
#define IN(k) (lo <= (k) && (k) < hi)
    volatile LAS unsigned* xb_st = (volatile LAS unsigned*)(lds + LDS_BYTES - 16);
    if (threadIdx.x < 4) xb_st[threadIdx.x] = 0u;
    __syncthreads();
    const XcdBarrier xbar = xcd_barrier_post((unsigned*)(a.ws + OFF_BAR), xb_st);
#define SYNC(k) do { if ((k) + 1 < hi) { if ((k) == 0) grid.sync(); else xcd_barrier(xbar); } } while (0)
    if (IN(0)) { { FRESH(); phase_prep(a, lds, tid, wave, lane); } SYNC(0); }
    if (IN(1)) { { FRESH(); row_pass<0>(a, 0, wave, lane); } SYNC(1); }
#pragma unroll 1
    for (int l = 0; l < DEPTH; ++l) {
        const int ph = 2 + 8 * l;
        const int Mrows = l < 3 ? TALL : TLAT;
        if (IN(ph + 0)) {
            pg8::Gemm g{(const bf16_t*)(a.ws + OFF_A), (const bf16_t*)(a.ws + OFF_WIN) + (size_t)l * INW * 1024, 1024};
            pg8::Order S; S.nM = Mrows / 256; S.nN = 7; S.nwg = S.nM * 7; S.G = G; S.c = blockIdx.x; S.extra = l < 3 ? 0 : 64; S.split = 0;
            pg8::EpiP E{(bf16_t*)(a.ws + OFF_P), (const float*)(a.ws + OFF_ROPE), (const float*)(a.ws + OFF_ROPE) + 1024};
            for (int rep = 0; rep < REP_GEMM; ++rep) pg8::gemm_phase<pg8::EpiP>(lds, g, S, E);
            SYNC(ph + 0);
        }
        if (IN(ph + 1)) {
            FRESH();
            for (int rep = 0; rep < REP_MIX; ++rep) {
                for (int it = blockIdx.x; it < 256; it += G) ssm_end_item(a, l, it, lds, tid, wave, lane);
                conv_phase(a, l, tid);
            }
            SYNC(ph + 1);
        }
        if (IN(ph + 2)) {
            FRESH();
            const int nit = l < 3 ? 1152 : 1024, nattn = l < 3 ? 2304 : 2048;
            for (int it = blockIdx.x; it < nit; it += G) {
                int b, ci; if (l < 3) { b = it / 36; ci = it % 36; } else { b = it >> 5; ci = 4 + (it & 31); }
                ssm_item<true>(a, l, b, ci, lds, tid, wave, lane);
            }
            {
                for (int it = blockIdx.x; it < 2048; it += G) attn_item(a, l, it, lds, tid, wave, lane);
                if (nattn > 2048 && G == 256) { if (blockIdx.x >= 128) { const int e = 2048 + 2 * ((int)blockIdx.x - 128); attn_item(a, l, e, lds, tid, wave, lane); attn_item(a, l, e + 1, lds, tid, wave, lane); } }
                else for (int it = 2048 + blockIdx.x; it < nattn; it += G) attn_item(a, l, it, lds, tid, wave, lane);
            }
            SYNC(ph + 2);
        }
        if (IN(ph + 3)) {
            pg8::Gemm g{(const bf16_t*)(a.ws + OFF_MIX), (const bf16_t*)(a.ws + OFF_WOUT) + (size_t)l * 1024 * 1024, 1024};
            pg8::Order S; S.nM = 256; S.nN = 4; S.nwg = 1024; S.G = G; S.c = blockIdx.x; S.extra = l < 3 ? 256 : 0; S.split = 1;
            pg8::EpiBf<0> E{(bf16_t*)(a.ws + OFF_MB), 1024, (bf16_t*)(a.ws + OFF_E)};
            for (int rep = 0; rep < REP_GEMM; ++rep) pg8::gemm_phase<pg8::EpiBf<0>>(lds, g, S, E);
            SYNC(ph + 3);
        }
        if (IN(ph + 4)) { { FRESH(); row_pass<1>(a, l, wave, lane); } SYNC(ph + 4); }
        if (IN(ph + 5)) {
            pg8::Gemm g{(const bf16_t*)(a.ws + OFF_A), (const bf16_t*)(a.ws + OFF_W1) + (size_t)l * DFF * 1024, 1024};
            pg8::Order S; S.nM = Mrows / 256; S.nN = 16; S.nwg = S.nM * 16; S.G = G; S.c = blockIdx.x; S.extra = 0; S.split = 0;
            pg8::EpiBf<1> E{(bf16_t*)(a.ws + OFF_Z), DFF, nullptr};
            for (int rep = 0; rep < REP_GEMM; ++rep) pg8::gemm_phase<pg8::EpiBf<1>>(lds, g, S, E);
            SYNC(ph + 5);
        }
        if (IN(ph + 6)) {
            pg8::Gemm g{(const bf16_t*)(a.ws + OFF_Z), (const bf16_t*)(a.ws + OFF_W2) + (size_t)l * 1024 * DFF, DFF};
            pg8::Order S; S.nM = 256; S.nN = 4; S.nwg = 1024; S.G = G; S.c = blockIdx.x; S.extra = l < 3 ? 256 : 0; S.split = 1;
            pg8::EpiBf<0> E{(bf16_t*)(a.ws + OFF_MB), 1024, (bf16_t*)(a.ws + OFF_E)};
            for (int rep = 0; rep < REP_GEMM; ++rep) pg8::gemm_phase<pg8::EpiBf<0>>(lds, g, S, E);
            SYNC(ph + 6);
        }
        if (IN(ph + 7)) { { FRESH(); row_pass<2>(a, l, wave, lane); } SYNC(ph + 7); }
    }
#undef IN
#undef SYNC
#undef FRESH
}

extern "C" void kernel_launch(void* const* d_in, const int* in_sizes, int n_in, void* d_out, int out_size, void* d_ws, size_t ws_size, hipStream_t stream) {
    static int grid = 0;
    if (grid == 0) {
        if (n_in != 23 || out_size != TLAT * DM || ws_size < WS_END) { fprintf(stderr, "kernel_launch: unexpected shapes (n_in %d out %d ws %zu need %zu)\n", n_in, out_size, ws_size, (size_t)WS_END); grid = -1; return; }
        int dev = 0, cus = 0, per_cu = 0;
        (void)hipGetDevice(&dev);
        (void)hipDeviceGetAttribute(&cus, hipDeviceAttributeMultiprocessorCount, dev);
        if (hipFuncSetAttribute((const void*)mk_fwd, hipFuncAttributeMaxDynamicSharedMemorySize, LDS_BYTES) != hipSuccess) { fprintf(stderr, "kernel_launch: hipFuncSetAttribute failed\n"); grid = -1; return; }
        (void)hipOccupancyMaxActiveBlocksPerMultiprocessor(&per_cu, (const void*)mk_fwd, 512, LDS_BYTES);
        if (per_cu < 1) { fprintf(stderr, "kernel_launch: occupancy query says %d blocks per CU\n", per_cu); per_cu = 1; }
        (void)hipGetLastError();
        grid = cus;
    }
    if (grid < 0) return;
    Args a{};
    for (int i = 0; i < 23; ++i) a.in[i] = (const float*)d_in[i];
    a.out = (float*)d_out; a.ws = (unsigned char*)d_ws; a.ph_lo = 0; a.ph_hi = 34;
    if (hipMemsetAsync((unsigned char*)d_ws + OFF_BAR, 0, XCD_BAR_WORDS * sizeof(unsigned), stream) != hipSuccess) { fprintf(stderr, "kernel_launch: hipMemsetAsync of the barrier words failed\n"); return; }
    void* args[] = {&a};
    hipError_t e = hipLaunchCooperativeKernel((const void*)mk_fwd, dim3(grid), dim3(512), args, LDS_BYTES, stream);
    if (e != hipSuccess) fprintf(stderr, "cooperative launch failed: %s (grid %d)\n", hipGetErrorString(e), grid);
}
```

```cpp
#include <hip/hip_runtime.h>
#include <hip/hip_cooperative_groups.h>
#include <cstdio>
#include <cstdint>
namespace cg = cooperative_groups;

#define LAS __attribute__((address_space(3)))
typedef unsigned short bf16_t;
typedef short bf16x8 __attribute__((ext_vector_type(8)));
typedef float f32x4 __attribute__((ext_vector_type(4)));
typedef float f32x2 __attribute__((ext_vector_type(2)));
typedef float f32x16 __attribute__((ext_vector_type(16)));
typedef unsigned u32x4 __attribute__((ext_vector_type(4)));
typedef unsigned u32x2 __attribute__((ext_vector_type(2)));

constexpr int DM = 1024, SEQ = 2048, NB = 32, CTXL = 256, DEPTH = 4;
constexpr int TLAT = NB * SEQ, TCTX = NB * CTXL, TALL = TLAT + TCTX;
constexpr int INW = 1792, DFF = 4096;
constexpr int LDS_BYTES = 139264;
#ifndef REP_GEMM
#define REP_GEMM 1
#endif
#ifndef REP_MIX
#define REP_MIX 1
#endif

constexpr size_t OFF_MOD  = 0;
constexpr size_t OFF_ROPE = OFF_MOD + (size_t)4 * 33 * 6144 * 4;
constexpr size_t OFF_LAMB = OFF_ROPE + 8192;
constexpr size_t OFF_BFR  = OFF_LAMB + 131072;
constexpr size_t OFF_CFR  = OFF_BFR + 1048576;
constexpr size_t OFF_E    = OFF_CFR + 524288;
constexpr size_t OFF_WIN  = OFF_E + 18874368;
constexpr size_t OFF_WOUT = OFF_WIN + 14680064;
constexpr size_t OFF_W1   = OFF_WOUT + 8388608;
constexpr size_t OFF_W2   = OFF_W1 + 33554432;
constexpr size_t OFF_WGLU = OFF_W2 + 33554432;
constexpr size_t OFF_HC   = OFF_WGLU + 524288;
constexpr size_t OFF_A    = OFF_HC + 33554432;
constexpr size_t OFF_MB   = OFF_A + 150994944;
constexpr size_t OFF_Z    = OFF_MB + 150994944;
constexpr size_t OFF_P    = OFF_Z;
constexpr size_t OFF_MIX  = OFF_Z + 264241152;
constexpr size_t OFF_E2   = OFF_Z + 603979776;
constexpr size_t OFF_BAR  = OFF_E2 + 18874368;
constexpr size_t WS_END   = OFF_BAR + 16384;

struct Args { const float* in[23]; float* out; unsigned char* ws; int ph_lo, ph_hi; };

__device__ __forceinline__ unsigned cvt_pk_bf16(float lo, float hi) { unsigned r; asm("v_cvt_pk_bf16_f32 %0, %1, %2" : "=v"(r) : "v"(lo), "v"(hi)); return r; }
__device__ __forceinline__ float bf_lo(unsigned u) { return __uint_as_float(u << 16); }
__device__ __forceinline__ float bf_hi(unsigned u) { return __uint_as_float(u & 0xffff0000u); }
__device__ __forceinline__ float bf2f(bf16_t x) { return __uint_as_float(((unsigned)x) << 16); }
#define DPP_ADD(v, ctrl) ((v) + __builtin_bit_cast(float, __builtin_amdgcn_update_dpp(0, __builtin_bit_cast(int, (v)), (ctrl), 0xF, 0xF, true)))
__device__ __forceinline__ float wave_sum(float v) {
    v = DPP_ADD(v, 0xB1);
    v = DPP_ADD(v, 0x4E);
    v = DPP_ADD(v, 0x141);
    v = DPP_ADD(v, 0x140);
    const int iv = __builtin_bit_cast(int, v);
    const float s0 = __builtin_bit_cast(float, __builtin_amdgcn_readlane(iv, 0)), s1 = __builtin_bit_cast(float, __builtin_amdgcn_readlane(iv, 16));
    const float s2 = __builtin_bit_cast(float, __builtin_amdgcn_readlane(iv, 32)), s3 = __builtin_bit_cast(float, __builtin_amdgcn_readlane(iv, 48));
    return (s0 + s1) + (s2 + s3);
}
#define LDS_WAIT() asm volatile("s_waitcnt lgkmcnt(0)" ::: "memory")
__device__ __forceinline__ int fresh_tid() { int t = threadIdx.x; asm volatile("" : "+v"(t)); return t; }
#define MFMA16(a, b, c) __builtin_amdgcn_mfma_f32_16x16x32_bf16((a), (b), (c), 0, 0, 0)
#define MFMA32(a, b, c) __builtin_amdgcn_mfma_f32_32x32x16_bf16((a), (b), (c), 0, 0, 0)

namespace pg8 {
constexpr int BM = 256, BK = 64, HALF = 128, HTB = HALF * BK * 2, STAGE_BYTES = 8 * HTB, NXCD = 8, WGM = 8;
__device__ __forceinline__ int lds_byte(int r, int c) { const int st = (r >> 4) * 2 + (c >> 5), rr = r & 15, cc = c & 31, ob = rr * 64 + cc * 2; return st * 1024 + (ob ^ (((ob >> 9) & 1) << 5)); }
__device__ __forceinline__ void stage_rc(int b, int& R, int& C) { const int st = b / 1024, sb = b % 1024, swz = sb ^ (((sb >> 9) & 1) << 5); R = (st >> 1) * 16 + swz / 64; C = (st & 1) * 32 + (swz % 64) / 2; }
__device__ __forceinline__ int perm32(int rho) { const int n = rho >> 4, i = rho & 15; return 8 * (i >> 2) + 4 * n + (i & 3); }
struct Unit { int pm, pn, half, kh; };
struct Gemm { const bf16_t* A; const bf16_t* Bt; int K; };
struct Order {
    int nM, nN, nwg, G, c, extra, split;
    __device__ __forceinline__ bool next(int i, Unit& u) const {
        const int L = i * G + c;
        u.half = 0; u.kh = 0;
        if (L >= nwg + extra) return false;
        if (L >= nwg) { const int e = L - nwg;
            if (split) { const int uu = e >> 1; u.half = 1; u.kh = e & 1; u.pm = nM + uu / nN; u.pn = uu % nN; return true; }
            u.pm = nM + (e >> 1); u.pn = (e & 1) ? 6 : 2; return true; }
        int wgid = L; { const int q = nwg / NXCD, r = nwg % NXCD, xcd = wgid % NXCD, off = wgid / NXCD; wgid = (xcd < r ? xcd * (q + 1) : r * (q + 1) + (xcd - r) * q) + off; }
        const int nig = WGM * nN, gid = wgid / nig, fm = gid * WGM, gsz = (nM - fm) < WGM ? (nM - fm) : WGM;
        u.pm = fm + ((wgid % nig) % gsz); u.pn = (wgid % nig) / gsz; return true;
    }
};
template <int ACT>
struct EpiBf {
    static constexpr bool PERM = true;
    bf16_t* O; int ldc; bf16_t* O2;
    __device__ __forceinline__ void operator()(const f32x4 (&acc)[2][2][4][2], const Unit& u, int wr, int wc, int fr, int fq) const {
        const int row0 = u.pm * BM + wr * 64 + fr, col0 = u.pn * BM + wc * 32 + 8 * fq;
        bf16_t* base = u.kh ? O2 - (size_t)TLAT * ldc : O;
#pragma unroll
        for (int ai = 0; ai < 2; ++ai)
#pragma unroll
            for (int m = 0; m < 4; ++m) { bf16_t* rowp = base + (size_t)(row0 + ai * HALF + m * 16) * ldc + col0;
#pragma unroll
                for (int bj = 0; bj < 2; ++bj) { f32x4 v0 = acc[ai][bj][m][0], v1 = acc[ai][bj][m][1];
                    if (ACT == 1) { v0.x = fmaxf(v0.x, 0.f); v0.y = fmaxf(v0.y, 0.f); v0.z = fmaxf(v0.z, 0.f); v0.w = fmaxf(v0.w, 0.f); v0 = v0 * v0;
                                    v1.x = fmaxf(v1.x, 0.f); v1.y = fmaxf(v1.y, 0.f); v1.z = fmaxf(v1.z, 0.f); v1.w = fmaxf(v1.w, 0.f); v1 = v1 * v1; }
                    u32x4 w; w.x = cvt_pk_bf16(v0.x, v0.y); w.y = cvt_pk_bf16(v0.z, v0.w); w.z = cvt_pk_bf16(v1.x, v1.y); w.w = cvt_pk_bf16(v1.z, v1.w);
                    *(u32x4*)(rowp + bj * HALF) = w; } }
    }
};
struct EpiP {
    static constexpr bool PERM = true;
    bf16_t* P; const float* rc; const float* rs;
    __device__ __forceinline__ void operator()(const f32x4 (&acc)[2][2][4][2], const Unit& u, int wr, int wc, int fr, int fq) const {
        const int row0 = u.pm * BM + wr * 64 + fr, col0 = u.pn * BM + wc * 32 + 8 * fq;
        const bool lat = u.pm < 256;
        const float qs = (u.pn < 2) ? 0.125f * 1.4426950408889634f : 1.f;
        const bool rope_any = lat && (u.pn <= 2);
        const float sgn = fq < 2 ? -1.f : 1.f;
        const bool colrot = (wc & 1) != 0;
        f32x4 c0[4], c1[4], s0[4], s1[4];
#pragma unroll
        for (int k = 0; k < 4; ++k) { c0[k] = (f32x4){1.f, 1.f, 1.f, 1.f}; c1[k] = c0[k]; s0[k] = (f32x4){0.f, 0.f, 0.f, 0.f}; s1[k] = s0[k]; }
        if (rope_any) {
#pragma unroll
            for (int k = 0; k < 4; ++k) {
                if (colrot || k < 2) {
                    const int row = colrot ? row0 + k * 16 : row0 + k * HALF; const int pos = row & 2047; const int pidx = colrot ? (pos & 63) : (pos >> 6); const int o = pidx * 16 + 8 * (fq & 1);
                    c0[k] = *(const f32x4*)(rc + o); c1[k] = *(const f32x4*)(rc + o + 4); s0[k] = *(const f32x4*)(rs + o) * sgn; s1[k] = *(const f32x4*)(rs + o + 4) * sgn; } }
        }
#pragma unroll
        for (int ai = 0; ai < 2; ++ai)
#pragma unroll
            for (int m = 0; m < 4; ++m) { const int row = row0 + ai * HALF + m * 16; bf16_t* rowp = P + (size_t)row * INW + col0;
                const f32x4 cc0 = colrot ? c0[m] : c0[ai], cc1 = colrot ? c1[m] : c1[ai], ss0 = colrot ? s0[m] : s0[ai], ss1 = colrot ? s1[m] : s1[ai];
#pragma unroll
                for (int bj = 0; bj < 2; ++bj) { f32x4 v0 = acc[ai][bj][m][0], v1 = acc[ai][bj][m][1];
                    const bool rope = lat && (u.pn < 2 || (u.pn == 2 && bj == 0));
                    if (rope) { f32x4 p0, p1;
#pragma unroll
                        for (int e = 0; e < 4; ++e) { p0[e] = __shfl_xor(v0[e], 32); p1[e] = __shfl_xor(v1[e], 32); }
                        v0 = v0 * cc0 + p0 * ss0; v1 = v1 * cc1 + p1 * ss1; }
                    v0 = v0 * qs; v1 = v1 * qs;
                    u32x4 w; w.x = cvt_pk_bf16(v0.x, v0.y); w.y = cvt_pk_bf16(v0.z, v0.w); w.z = cvt_pk_bf16(v1.x, v1.y); w.w = cvt_pk_bf16(v1.z, v1.w);
                    *(u32x4*)(rowp + bj * HALF) = w; } }
    }
};

template <class Epi>
__device__ __forceinline__ void gemm_phase(LAS unsigned char* lds, const Gemm g, const Order& S, const Epi& E) {
    const int tid = fresh_tid(), wid = __builtin_amdgcn_readfirstlane(tid >> 6), lane = tid & 63, wr = wid >> 2, wc = wid & 3, fr = lane & 15, fq = lane >> 4;
    const int K = g.K, nt = K / BK;
    unsigned voffA[2], voffB[2];
#pragma unroll
    for (int i = 0; i < 2; ++i) { int R, C; stage_rc(tid * 16 + i * 8192, R, C); const int Rb = Epi::PERM ? ((R & ~31) + perm32(R & 31)) : R;
        voffA[i] = (unsigned)(R * K + C) * 2u; voffB[i] = (unsigned)(Rb * K + C) * 2u; }
    const size_t kstep = (size_t)(BK * 2);
    const size_t hstep = (size_t)HALF * K * 2;
    const size_t tstep = 2 * hstep;
    const unsigned ldsw = (unsigned)wid * 1024u;
    const int aoff = lds_byte(wr * 64 + fr, fq * 8), boff = lds_byte(wc * 32 + fr, fq * 8);
#define PG8_SA(b, h) (((b) * 2 + (h)) * HTB)
#define PG8_SB(b, h) ((4 + (b) * 2 + (h)) * HTB)
#define PG8_STAGE(bufoff, gbase, voff) do { _Pragma("unroll") for (int _i = 0; _i < 2; ++_i) \
        __builtin_amdgcn_global_load_lds((const unsigned*)((const char*)(gbase) + (voff)[_i]), (LAS unsigned*)(lds + (bufoff) + ldsw + _i * 8192), 16, 0, 0); } while (0)
#define PG8_LDA(dst, b, h) do { _Pragma("unroll") for (int m = 0; m < 4; ++m) _Pragma("unroll") for (int k = 0; k < 2; ++k) dst[m][k] = *(const LAS bf16x8*)(lds + PG8_SA(b, h) + aoff + m * 2048 + k * 1024); } while (0)
#define PG8_LDB(dst, b, h) do { _Pragma("unroll") for (int n = 0; n < 2; ++n) _Pragma("unroll") for (int k = 0; k < 2; ++k) dst[n][k] = *(const LAS bf16x8*)(lds + PG8_SB(b, h) + boff + n * 2048 + k * 1024); } while (0)
#define PG8_MMA(ai, bj, At, Bt) do { __builtin_amdgcn_s_setprio(1); _Pragma("unroll") for (int m = 0; m < 4; ++m) _Pragma("unroll") for (int n = 0; n < 2; ++n) _Pragma("unroll") for (int k = 0; k < 2; ++k) \
        acc[ai][bj][m][n] = __builtin_amdgcn_mfma_f32_16x16x32_bf16(Bt[n][k], At[m][k], acc[ai][bj][m][n], 0, 0, 0); __builtin_amdgcn_s_setprio(0); } while (0)
#define PG8_WAIT_V(n) asm volatile("s_waitcnt vmcnt(" #n ")" ::: "memory")
#define PG8_WAIT_L(n) asm volatile("s_waitcnt lgkmcnt(" #n ")" ::: "memory")
#define PG8_BAR __builtin_amdgcn_s_barrier()
#define PG8_SCHED __builtin_amdgcn_sched_barrier(0)
    Unit cur, nxt; int ui = 0;
    if (!S.next(0, cur)) return;
    f32x4 acc[2][2][4][2];
#pragma unroll
    for (int a = 0; a < 2; ++a)
#pragma unroll
        for (int b = 0; b < 2; ++b)
#pragma unroll
            for (int m = 0; m < 4; ++m)
#pragma unroll
                for (int n = 0; n < 2; ++n) acc[a][b][m][n] = (f32x4){0.f, 0.f, 0.f, 0.f};
    bf16x8 At[4][2], B0[2][2], B1[2][2];
    const size_t khoff = (size_t)K;
    const char* cA = (const char*)g.A + (size_t)cur.pm * tstep + (cur.kh ? khoff : 0); const char* cB = (const char*)g.Bt + (size_t)cur.pn * tstep + (cur.kh ? khoff : 0);
    PG8_STAGE(PG8_SB(0, 0), cB, voffB); PG8_STAGE(PG8_SB(0, 1), cB + hstep, voffB); PG8_STAGE(PG8_SA(0, 0), cA, voffA); PG8_STAGE(PG8_SA(0, 1), cA + hstep, voffA);
    if (wr == 1) PG8_BAR;
    PG8_WAIT_V(2); PG8_BAR;
    PG8_STAGE(PG8_SB(1, 0), cB + kstep, voffB); PG8_STAGE(PG8_SA(1, 0), cA + kstep, voffA); PG8_STAGE(PG8_SB(1, 1), cB + hstep + kstep, voffB);
    PG8_WAIT_V(6); PG8_BAR;
    for (;;) {
        const bool has_next = S.next(ui + 1, nxt);
        const char* nA = has_next ? (const char*)g.A + (size_t)nxt.pm * tstep + (nxt.kh ? khoff : 0) : cA; const char* nB = has_next ? (const char*)g.Bt + (size_t)nxt.pn * tstep + (nxt.kh ? khoff : 0) : cB;
        const int cnt = cur.half ? (nt >> 1) : nt;
        for (int t = 0; t < cnt; t += 2) {
            const bool last = (t == cnt - 2);
            const char* a1 = cA + (size_t)(t + 1) * kstep;
            const char* a2 = last ? nA : cA + (size_t)(t + 2) * kstep; const char* b2 = last ? nB : cB + (size_t)(t + 2) * kstep;
            const char* a3 = a2 + kstep; const char* b3 = b2 + kstep;
            PG8_LDB(B0, 0, 0); PG8_LDB(B1, 0, 1); PG8_SCHED; PG8_LDA(At, 0, 0); PG8_STAGE(PG8_SA(1, 1), a1 + hstep, voffA);
            PG8_WAIT_V(8); PG8_WAIT_L(0); PG8_BAR; PG8_MMA(0, 0, At, B0); PG8_MMA(0, 1, At, B1); PG8_BAR; PG8_SCHED;
            PG8_LDA(At, 0, 1); PG8_STAGE(PG8_SB(0, 0), b2, voffB); PG8_STAGE(PG8_SB(0, 1), b2 + hstep, voffB); PG8_STAGE(PG8_SA(0, 0), a2, voffA);
            PG8_WAIT_V(8); PG8_WAIT_L(0); PG8_BAR; PG8_MMA(1, 0, At, B0); PG8_MMA(1, 1, At, B1); PG8_BAR; PG8_SCHED;
            PG8_LDB(B0, 1, 0); PG8_LDB(B1, 1, 1); PG8_SCHED; PG8_LDA(At, 1, 0); PG8_STAGE(PG8_SA(0, 1), a2 + hstep, voffA);
            PG8_WAIT_V(8); PG8_WAIT_L(0); PG8_BAR; PG8_MMA(0, 0, At, B0); PG8_MMA(0, 1, At, B1); PG8_BAR; PG8_SCHED;
            PG8_LDA(At, 1, 1); PG8_STAGE(PG8_SB(1, 0), b3, voffB); PG8_STAGE(PG8_SB(1, 1), b3 + hstep, voffB); PG8_STAGE(PG8_SA(1, 0), a3, voffA);
            PG8_WAIT_V(8); PG8_WAIT_L(0); PG8_BAR; PG8_MMA(1, 0, At, B0); PG8_MMA(1, 1, At, B1); PG8_BAR; PG8_SCHED;
        }
        if (wr == 0) PG8_BAR;
        E(acc, cur, wr, wc, fr, fq);
        if (!has_next) break;
#pragma unroll
        for (int a = 0; a < 2; ++a)
#pragma unroll
            for (int b = 0; b < 2; ++b)
#pragma unroll
                for (int m = 0; m < 4; ++m)
#pragma unroll
                    for (int n = 0; n < 2; ++n) acc[a][b][m][n] = (f32x4){0.f, 0.f, 0.f, 0.f};
        cur = nxt; cA = nA; cB = nB; ++ui;
        if (wr == 1) PG8_BAR;
    }
    PG8_WAIT_V(0);
    PG8_BAR;
#undef PG8_SA
#undef PG8_SB
#undef PG8_STAGE
#undef PG8_LDA
#undef PG8_LDB
#undef PG8_MMA
#undef PG8_WAIT_V
#undef PG8_WAIT_L
#undef PG8_BAR
#undef PG8_SCHED
}
}

__device__ __forceinline__ void transpose_item(const float* W, int K, int N, bf16_t* WT, LAS float* scr, int item, int lane) {
    const int nblk = N / 64, kb = item / nblk, nb = item % nblk, k0 = 32 * kb, n0 = 64 * nb;
    const int lr4 = lane >> 4, c4 = lane & 15;
    f32x4 v[8];
#pragma unroll
    for (int i = 0; i < 8; ++i) v[i] = __builtin_nontemporal_load((const f32x4*)(W + (size_t)(k0 + 4 * i + lr4) * N + n0 + 4 * c4));
#pragma unroll
    for (int i = 0; i < 8; ++i) { LAS float* d = scr + (4 * i + lr4) * 65 + 4 * c4; d[0] = v[i].x; d[1] = v[i].y; d[2] = v[i].z; d[3] = v[i].w; }
    LDS_WAIT();
    const int kc = lane & 3;
#pragma unroll
    for (int jj = 0; jj < 4; ++jj) { const int n = (lane >> 2) + 16 * jj; const LAS float* sp = scr + (8 * kc) * 65 + n;
        u32x4 o; o.x = cvt_pk_bf16(sp[0 * 65], sp[1 * 65]); o.y = cvt_pk_bf16(sp[2 * 65], sp[3 * 65]); o.z = cvt_pk_bf16(sp[4 * 65], sp[5 * 65]); o.w = cvt_pk_bf16(sp[6 * 65], sp[7 * 65]);
        *(u32x4*)(WT + (size_t)(n0 + n) * K + k0 + 8 * kc) = o; }
    LDS_WAIT();
}

__device__ __forceinline__ void ssm_tables(const Args& a, int q, int lane) {
    const float* lam_re = a.in[10]; const float* lam_im = a.in[11]; const float* log_dt = a.in[12];
    const float* b_re = a.in[13]; const float* b_im = a.in[14]; const float* c_re = a.in[15]; const float* c_im = a.in[16];
    f32x4* LAMB = (f32x4*)(a.ws + OFF_LAMB); u32x4* BFR = (u32x4*)(a.ws + OFF_BFR); u32x4* CFR = (u32x4*)(a.ws + OFF_CFR);
    const float lr = lam_re[q * 64 + lane], li = lam_im[q * 64 + lane];
    const float dt = expf(log_dt[q]);
    const float er = expf(lr * dt);
    float sn, cs; sincosf(li * dt, &sn, &cs);
    const float are = er * cs, aim = er * sn;
    float pr = are, pi = aim;
#pragma unroll
    for (int i = 0; i < 6; ++i) { const float nr = pr * pr - pi * pi, ni = 2.f * pr * pi; pr = nr; pi = ni; }
    LAMB[q * 64 + lane] = (f32x4){are, aim, pr, pi};
    const float den = lr * lr + li * li;
    const float cr = ((are - 1.f) * lr + aim * li) / den, ci = (aim * lr - (are - 1.f) * li) / den;
    const int i0 = 8 * ((lane >> 4) & 1), lo = lane >> 5;
#pragma unroll
    for (int nt = 0; nt < 8; ++nt) {
        const int n = 16 * nt + (lane & 15), pp = n & 63, part = n >> 6;
        const float crp = __shfl(cr, pp), cip = __shfl(ci, pp);
        const float* br = b_re + ((size_t)q * 64 + pp) * 16 + i0; const float* bi = b_im + ((size_t)q * 64 + pp) * 16 + i0;
        float v[8];
#pragma unroll
        for (int j = 0; j < 8; ++j) { const float x = part == 0 ? (crp * br[j] - cip * bi[j]) : (crp * bi[j] + cip * br[j]);
            const float hi = __uint_as_float(cvt_pk_bf16(x, 0.f) << 16);
            v[j] = lo ? (x - hi) : x; }
        u32x4 o; o.x = cvt_pk_bf16(v[0], v[1]); o.y = cvt_pk_bf16(v[2], v[3]); o.z = cvt_pk_bf16(v[4], v[5]); o.w = cvt_pk_bf16(v[6], v[7]);
        BFR[(q * 8 + nt) * 64 + lane] = o;
    }
#pragma unroll
    for (int ks = 0; ks < 4; ++ks) {
        const int i = lane & 15, pbase = 32 * (ks & 1) + 8 * (lane >> 4), part = ks >> 1;
        const float* src = (part == 0 ? c_re : c_im) + ((size_t)q * 16 + i) * 64 + pbase;
        const float sg = part == 0 ? 1.f : -1.f;
        u32x4 o; o.x = cvt_pk_bf16(sg * src[0], sg * src[1]); o.y = cvt_pk_bf16(sg * src[2], sg * src[3]); o.z = cvt_pk_bf16(sg * src[4], sg * src[5]); o.w = cvt_pk_bf16(sg * src[6], sg * src[7]);
        CFR[(q * 4 + ks) * 64 + lane] = o;
    }
}

__device__ __forceinline__ void adaln_item(const Args& a, int it, LAS float* cact, int tid, int wave, int lane) {
    const int l = it / 96, cc = it % 96;
    const float* c = a.in[1]; const float* cctx = a.in[3]; const float* b_ada = a.in[5];
    float* MOD = (float*)(a.ws + OFF_MOD);
    for (int idx = tid; idx < 33 * 1024; idx += 512) { const int b = idx >> 10, k = idx & 1023; const float v = b < 32 ? c[b * 1024 + k] : cctx[k]; cact[idx] = v / (1.f + expf(-v)); }
    __syncthreads();
    const float* W = a.in[4] + (size_t)l * 1024 * 6144 + cc * 64 + lane;
    float acc[33];
#pragma unroll
    for (int b = 0; b < 33; ++b) acc[b] = 0.f;
    const int kbase = wave * 128;
#pragma unroll 2
    for (int k4 = 0; k4 < 32; ++k4) { const int k = kbase + 4 * k4;
        const float w0 = __builtin_nontemporal_load(W + (size_t)(k + 0) * 6144), w1 = __builtin_nontemporal_load(W + (size_t)(k + 1) * 6144), w2 = __builtin_nontemporal_load(W + (size_t)(k + 2) * 6144), w3 = __builtin_nontemporal_load(W + (size_t)(k + 3) * 6144);
#pragma unroll
        for (int b = 0; b < 33; ++b) { const f32x4 cv = *(const LAS f32x4*)(cact + b * 1024 + k); acc[b] += cv.x * w0 + cv.y * w1 + cv.z * w2 + cv.w * w3; } }
    __syncthreads();
    LAS float* red = cact;
#pragma unroll
    for (int b = 0; b < 33; ++b) red[(wave * 33 + b) * 64 + lane] = acc[b];
    __syncthreads();
    for (int idx = tid; idx < 33 * 64; idx += 512) { const int b = idx >> 6, ln = idx & 63; float s = 0.f;
#pragma unroll
        for (int w = 0; w < 8; ++w) s += red[(w * 33 + b) * 64 + ln];
        MOD[(size_t)(l * 33 + b) * 6144 + cc * 64 + ln] = s + b_ada[l * 6144 + cc * 64 + ln]; }
    __syncthreads();
}

__device__ __forceinline__ void phase_prep(const Args& a, LAS unsigned char* lds, int tid, int wave, int lane) {
    const int G = gridDim.x, gw = blockIdx.x * 8 + wave, NGW = G * 8;
    for (int q = gw; q < 128; q += NGW) ssm_tables(a, q, lane);
    if (blockIdx.x == G - 1) { float* rc = (float*)(a.ws + OFF_ROPE); float* rs = rc + 1024;
        for (int idx = tid; idx < 1024; idx += 512) { const int pidx = idx >> 4, i = idx & 15; const float fr = powf(10000.f, -(float)i / 16.f); float s, c; sincosf((float)pidx * fr, &s, &c); rc[idx] = c; rs[idx] = s; } }
    LAS float* scr = (LAS float*)(lds + wave * 8448);
    constexpr int I_IN = 32 * 28, I_OUT = 32 * 16, I_1 = 32 * 64, I_2 = 128 * 16, I_G = 8 * 4, I_L = I_IN + I_OUT + I_1 + I_2 + I_G;
    for (int it = gw; it < DEPTH * I_L; it += NGW) {
        const int l = it / I_L; int r = it % I_L;
        if (r < I_IN) { transpose_item(a.in[7] + (size_t)l * 1024 * 1792, 1024, 1792, (bf16_t*)(a.ws + OFF_WIN) + (size_t)l * 1792 * 1024, scr, r, lane); continue; } r -= I_IN;
        if (r < I_OUT) { transpose_item(a.in[20] + (size_t)l * 1024 * 1024, 1024, 1024, (bf16_t*)(a.ws + OFF_WOUT) + (size_t)l * 1024 * 1024, scr, r, lane); continue; } r -= I_OUT;
        if (r < I_1) { transpose_item(a.in[21] + (size_t)l * 1024 * 4096, 1024, 4096, (bf16_t*)(a.ws + OFF_W1) + (size_t)l * 4096 * 1024, scr, r, lane); continue; } r -= I_1;
        if (r < I_2) { transpose_item(a.in[22] + (size_t)l * 4096 * 1024, 4096, 1024, (bf16_t*)(a.ws + OFF_W2) + (size_t)l * 1024 * 4096, scr, r, lane); continue; } r -= I_2;
        transpose_item(a.in[18] + (size_t)l * 256 * 256, 256, 256, (bf16_t*)(a.ws + OFF_WGLU) + (size_t)l * 256 * 256, scr, r, lane);
    }
    __syncthreads();
    for (int it = blockIdx.x; it < 4 * 96; it += G) adaln_item(a, it, (LAS float*)lds, tid, wave, lane);
}

typedef _Float16 f16x4 __attribute__((ext_vector_type(4)));
__device__ __forceinline__ unsigned char* h16_row(const Args& a, int r0, bool isctx, bool hop) {
    if (isctx) return a.ws + OFF_HC + (size_t)(r0 - TLAT) * 2048;
    if (!hop) return (unsigned char*)a.out + (size_t)r0 * 2048;
    if (r0 < 41984) return a.ws + OFF_Z + (size_t)536870912 + (size_t)r0 * 2048;
    if (r0 < 58368) return a.ws + OFF_HC + (size_t)(r0 - 41984) * 2048;
    return a.ws + OFF_E + (size_t)(r0 - 58368) * 2048;
}
template <int MODE>
__device__ __forceinline__ void row_pass(const Args& a, int l, int wave, int lane) {
    const int gw = blockIdx.x * 8 + wave, NGW = gridDim.x * 8;
    const float* normg = a.in[6];
    const float* MOD = (const float*)(a.ws + OFF_MOD);
    bf16_t* Abuf = (bf16_t*)(a.ws + OFF_A); const bf16_t* MBuf = (const bf16_t*)(a.ws + OFF_MB);
    const int nrows = (MODE == 0 || l < 3) ? TALL : TLAT;
    const int ntask = nrows >> 3;
    const bool do_a = (MODE != 2) || (l < 3);
    const bool in_f32 = (MODE == 0) || (MODE == 1 && l == 0);
    const bool out_f32 = (MODE == 2 && l == 3);
    for (int task = gw; task < ntask; task += NGW) {
        const int r0 = task << 3;
        const bool isctx = r0 >= TLAT;
        const int b = isctx ? 32 : (r0 >> 11);
        const float* mod = MOD + (size_t)(l * 33 + b) * 6144;
        f32x4 V[4], SA[4], SB[4];
#pragma unroll
        for (int j = 0; j < 4; ++j) { const int col = 4 * lane + 256 * j;
            V[j] = (f32x4){0.f, 0.f, 0.f, 0.f}; SA[j] = V[j]; SB[j] = V[j];
            if (MODE == 0) { SA[j] = *(const f32x4*)(normg + col) * (*(const f32x4*)(mod + 1024 + col) + 1.f); SB[j] = *(const f32x4*)(mod + col); }
            if (MODE == 1) { V[j] = *(const f32x4*)(mod + 2048 + col) * *(const f32x4*)(normg + (l * 4 + 1) * 1024 + col);
                SA[j] = *(const f32x4*)(normg + (l * 4 + 2) * 1024 + col) * (*(const f32x4*)(mod + 4096 + col) + 1.f); SB[j] = *(const f32x4*)(mod + 3072 + col); }
            if (MODE == 2) { V[j] = *(const f32x4*)(mod + 5120 + col) * *(const f32x4*)(normg + (l * 4 + 3) * 1024 + col);
                if (l < 3) { const float* mod2 = MOD + (size_t)((l + 1) * 33 + b) * 6144;
                    SA[j] = *(const f32x4*)(normg + ((l + 1) * 4 + 0) * 1024 + col) * (*(const f32x4*)(mod2 + 1024 + col) + 1.f); SB[j] = *(const f32x4*)(mod2 + col); } }
        }
        const unsigned char* hin0; unsigned char* hout0;
        if (in_f32) hin0 = (const unsigned char*)(isctx ? a.in[2] + (size_t)(r0 - TLAT) * 1024 : a.in[0] + (size_t)r0 * 1024);
        else hin0 = h16_row(a, r0, isctx, MODE == 2 && l == 3);
        if (out_f32) hout0 = (unsigned char*)(a.out + (size_t)r0 * 1024);
        else hout0 = h16_row(a, r0, isctx, MODE == 1 && l == 3);
        const size_t pin = in_f32 ? 4096 : 2048, pout = out_f32 ? 4096 : 2048;
        const bf16_t* mrow0 = MBuf + (size_t)r0 * 1024;
        u32x4 hq[4][4]; u32x2 mq[4][4];
#define RP_LOAD(slot, rr_) do { const unsigned char* hin_ = hin0 + (size_t)(rr_) * pin; \
        _Pragma("unroll") for (int j = 0; j < 4; ++j) { \
            if (in_f32) hq[slot][j] = __builtin_nontemporal_load((const u32x4*)(hin_ + 16 * lane + 1024 * j)); \
            else { const u32x2 t_ = __builtin_nontemporal_load((const u32x2*)(hin_ + 8 * lane + 512 * j)); hq[slot][j] = (u32x4){t_.x, t_.y, 0u, 0u}; } \
            if (MODE != 0) mq[slot][j] = __builtin_nontemporal_load((const u32x2*)(mrow0 + (size_t)(rr_) * 1024 + 4 * lane + 256 * j)); } } while (0)
        RP_LOAD(0, 0); RP_LOAD(1, 1); RP_LOAD(2, 2); RP_LOAD(3, 3);
#pragma unroll
        for (int rr = 0; rr < 8; ++rr) {
            const int r = r0 + rr;
            unsigned char* hout = hout0 + (size_t)rr * pout;
            u32x4 hw[4]; u32x2 mw[4];
#pragma unroll
            for (int j = 0; j < 4; ++j) { hw[j] = hq[rr & 3][j]; if (MODE != 0) mw[j] = mq[rr & 3][j]; }
            if (rr + 4 < 8) RP_LOAD(rr & 3, rr + 4);
            f32x4 h[4];
#pragma unroll
            for (int j = 0; j < 4; ++j) {
                if (in_f32) h[j] = __builtin_bit_cast(f32x4, hw[j]);
                else { const u32x2 t = {hw[j].x, hw[j].y}; h[j] = __builtin_convertvector(__builtin_bit_cast(f16x4, t), f32x4); } }
            if (MODE != 0) {
                f32x4 mv[4]; float ss = 0.f;
#pragma unroll
                for (int j = 0; j < 4; ++j) { const u32x2 w = mw[j];
                    mv[j] = (f32x4){bf_lo(w.x), bf_hi(w.x), bf_lo(w.y), bf_hi(w.y)};
                    if (isctx) { const u32x2 w2 = *(const u32x2*)((const bf16_t*)(a.ws + OFF_E) + (size_t)(r - TLAT) * 1024 + 4 * lane + 256 * j);
                        mv[j] = mv[j] + (f32x4){bf_lo(w2.x), bf_hi(w2.x), bf_lo(w2.y), bf_hi(w2.y)}; }
                    ss += mv[j].x * mv[j].x + mv[j].y * mv[j].y + mv[j].z * mv[j].z + mv[j].w * mv[j].w; }
                ss = wave_sum(ss);
                const float rinv = rsqrtf(ss * (1.f / 1024.f) + 1e-6f);
#pragma unroll
                for (int j = 0; j < 4; ++j) { h[j] = h[j] + V[j] * (mv[j] * rinv);
                    if (out_f32) __builtin_nontemporal_store(h[j], (f32x4*)(hout + 16 * lane + 1024 * j));
                    else __builtin_nontemporal_store(__builtin_bit_cast(u32x2, __builtin_convertvector(h[j], f16x4)), (u32x2*)(hout + 8 * lane + 512 * j)); }
            }
            if (do_a) {
                float ss = 0.f;
#pragma unroll
                for (int j = 0; j < 4; ++j) ss += h[j].x * h[j].x + h[j].y * h[j].y + h[j].z * h[j].z + h[j].w * h[j].w;
                ss = wave_sum(ss);
                const float rinv = rsqrtf(ss * (1.f / 1024.f) + 1e-6f);
#pragma unroll
                for (int j = 0; j < 4; ++j) { const f32x4 o = (h[j] * rinv) * SA[j] + SB[j];
                    u32x2 w; w.x = cvt_pk_bf16(o.x, o.y); w.y = cvt_pk_bf16(o.z, o.w);
                    *(u32x2*)(Abuf + (size_t)r * 1024 + 4 * lane + 256 * j) = w; }
            }
        }
#undef RP_LOAD
    }
}

__device__ __forceinline__ void attn_item(const Args& a, int l, int item, LAS unsigned char* lds, int tid, int wave, int lane) {
    const bf16_t* P = (const bf16_t*)(a.ws + OFF_P);
    bf16_t* MIX = (bf16_t*)(a.ws + OFF_MIX);
    int b, kvh, qb; bool latq;
    if (item < 2048) { latq = true; b = item >> 6; kvh = (item >> 5) & 1; qb = item & 31; }
    else { const int it = item - 2048; latq = false; b = it >> 3; kvh = (it >> 2) & 1; qb = it & 3; }
    const int hq = wave >> 1, qhalf = wave & 1, head = kvh * 4 + hq;
    const int qpos0 = qb * 64 + qhalf * 32;
    const size_t seq0 = latq ? (size_t)b * SEQ : (size_t)TLAT + (size_t)b * CTXL;
    const size_t qrow0 = seq0 + qpos0;
    int lat_lo = 0, nlat = 0;
    if (latq) { lat_lo = qb * 64 - 128; if (lat_lo < 0) lat_lo = 0; int lat_hi = qb * 64 + 192; if (lat_hi > SEQ) lat_hi = SEQ; nlat = (lat_hi - lat_lo) >> 6; }
    const int ntiles = nlat + 4;
    const int lr = lane & 31, h = lane >> 5;
    bf16x8 qf[4];
#pragma unroll
    for (int ks = 0; ks < 4; ++ks) qf[ks] = *(const bf16x8*)(P + (qrow0 + lr) * INW + head * 64 + 16 * ks + 8 * h);
    const float sinkv = a.in[9][l * 8 + head] * 1.4426950408889634f;
    float mrun = sinkv, ls = (h == 0 ? 1.f : 0.f);
    f32x16 Y[2];
#pragma unroll
    for (int i = 0; i < 2; ++i)
#pragma unroll
        for (int e = 0; e < 16; ++e) Y[i][e] = 0.f;
    const int kkey = tid >> 3, kdc = tid & 7;
    u32x4 kreg, vreg;
#define ATT_TROW(i) ((i) < nlat ? (size_t)b * SEQ + lat_lo + 64 * (i) : (size_t)TLAT + (size_t)b * CTXL + 64 * ((i) - nlat))
#define ATT_LOAD(i) do { const size_t trow = ATT_TROW(i); \
        kreg = *(const u32x4*)(P + (trow + kkey) * INW + 512 + kvh * 64 + 8 * kdc); \
        vreg = *(const u32x4*)(P + (trow + lane) * INW + 640 + kvh * 64 + 8 * wave); } while (0)
#define ATT_WRITE(buf) do { *(LAS u32x4*)(lds + (buf) * 9216 + kkey * 144 + kdc * 16) = kreg; \
        LAS bf16_t* vt = (LAS bf16_t*)(lds + 18432 + (buf) * 9216) + (8 * wave) * 72 + lane; \
        vt[0 * 72] = (bf16_t)(vreg.x & 0xffffu); vt[1 * 72] = (bf16_t)(vreg.x >> 16); vt[2 * 72] = (bf16_t)(vreg.y & 0xffffu); vt[3 * 72] = (bf16_t)(vreg.y >> 16); \
        vt[4 * 72] = (bf16_t)(vreg.z & 0xffffu); vt[5 * 72] = (bf16_t)(vreg.z >> 16); vt[6 * 72] = (bf16_t)(vreg.w & 0xffffu); vt[7 * 72] = (bf16_t)(vreg.w >> 16); } while (0)
    ATT_LOAD(0); ATT_WRITE(0);
    __syncthreads();
    for (int i = 0; i < ntiles; ++i) {
        if (i + 1 < ntiles) ATT_LOAD(i + 1);
        const bool lat = i < nlat; const int k0 = lat_lo + 64 * i;
        const bool skip = lat && (k0 > qpos0 + 159 || k0 < qpos0 - 191);
        if (!skip) {
            const LAS unsigned char* Kb = lds + (i & 1) * 9216; const LAS unsigned char* Vb = lds + 18432 + (i & 1) * 9216;
            f32x16 X[2];
#pragma unroll
            for (int i2 = 0; i2 < 2; ++i2)
#pragma unroll
                for (int e = 0; e < 16; ++e) X[i2][e] = 0.f;
#pragma unroll
            for (int ks = 0; ks < 4; ++ks) {
                const bf16x8 kf0 = *(const LAS bf16x8*)(Kb + lr * 144 + (16 * ks + 8 * h) * 2);
                const bf16x8 kf1 = *(const LAS bf16x8*)(Kb + (32 + lr) * 144 + (16 * ks + 8 * h) * 2);
                X[0] = MFMA32(kf0, qf[ks], X[0]); X[1] = MFMA32(kf1, qf[ks], X[1]);
            }
            const bool needmask = lat && (k0 > qpos0 + 65 || k0 < qpos0 - 97);
            if (needmask) {
#pragma unroll
                for (int mt = 0; mt < 2; ++mt) { const int base = (k0 + 32 * mt + 4 * h) - (qpos0 + lr);
#pragma unroll
                    for (int e = 0; e < 16; ++e) { const int diff = base + (e & 3) + 8 * (e >> 2); if (diff > 128 || diff < -128) X[mt][e] = -1e30f; } }
            }
            {
                float mx = X[0][0];
#pragma unroll
                for (int e = 1; e < 16; ++e) mx = fmaxf(mx, X[0][e]);
#pragma unroll
                for (int e = 0; e < 16; ++e) mx = fmaxf(mx, X[1][e]);
                mx = fmaxf(mx, __shfl_xor(mx, 32));
                if (__builtin_amdgcn_ballot_w64(mx > mrun) != 0ull) {
                    const float mnew = fmaxf(mrun, mx);
                    const float alpha = __builtin_amdgcn_exp2f(mrun - mnew);
                    mrun = mnew;
                    ls = ls * alpha;
                    Y[0] = Y[0] * alpha; Y[1] = Y[1] * alpha;
                }
                float sum = 0.f;
#pragma unroll
                for (int mt = 0; mt < 2; ++mt)
#pragma unroll
                    for (int e = 0; e < 16; ++e) { const float p = __builtin_amdgcn_exp2f(X[mt][e] - mrun); X[mt][e] = p; sum += p; }
                ls += sum;
            }
#pragma unroll
            for (int mt = 0; mt < 2; ++mt)
#pragma unroll
                for (int s = 0; s < 2; ++s) {
                    u32x4 w; w.x = cvt_pk_bf16(X[mt][8 * s + 0], X[mt][8 * s + 1]); w.y = cvt_pk_bf16(X[mt][8 * s + 2], X[mt][8 * s + 3]);
                    w.z = cvt_pk_bf16(X[mt][8 * s + 4], X[mt][8 * s + 5]); w.w = cvt_pk_bf16(X[mt][8 * s + 6], X[mt][8 * s + 7]);
                    const bf16x8 pf = __builtin_bit_cast(bf16x8, w);
#pragma unroll
                    for (int dt = 0; dt < 2; ++dt) {
                        const LAS unsigned char* vp = Vb + (32 * dt + lr) * 144 + (32 * mt + 16 * s + 4 * h) * 2;
                        const u32x2 v0 = *(const LAS u32x2*)vp, v1 = *(const LAS u32x2*)(vp + 16);
                        const u32x4 vv = {v0.x, v0.y, v1.x, v1.y};
                        const bf16x8 vf = __builtin_bit_cast(bf16x8, vv);
                        Y[dt] = MFMA32(vf, pf, Y[dt]);
                    }
                }
        }
        if (i + 1 < ntiles) ATT_WRITE((i + 1) & 1);
        __syncthreads();
    }
    {
        const float lt = ls + __shfl_xor(ls, 32);
        const float inv = __builtin_amdgcn_rcpf(lt);
        LAS unsigned char* ot = lds + wave * 4608;
#pragma unroll
        for (int dt = 0; dt < 2; ++dt)
#pragma unroll
            for (int rg = 0; rg < 4; ++rg) { u32x2 w; w.x = cvt_pk_bf16(Y[dt][4 * rg + 0] * inv, Y[dt][4 * rg + 1] * inv); w.y = cvt_pk_bf16(Y[dt][4 * rg + 2] * inv, Y[dt][4 * rg + 3] * inv);
                *(LAS u32x2*)(ot + lr * 144 + (32 * dt + 8 * rg + 4 * h) * 2) = w; }
        LDS_WAIT();
#pragma unroll
        for (int k = 0; k < 4; ++k) { const int row = 8 * k + (lane >> 3), ch = lane & 7;
            const u32x4 w = *(const LAS u32x4*)(ot + row * 144 + ch * 16);
            *(u32x4*)(MIX + (qrow0 + row) * 1024 + head * 64 + ch * 8) = w; }
        __syncthreads();
    }
#undef ATT_TROW
#undef ATT_LOAD
#undef ATT_WRITE
}

__device__ __forceinline__ float gelu_tanh(float y) {
    const float u = 0.7978845608028654f * (y + 0.044715f * y * y * y);
    const float t = 1.f - 2.f * __builtin_amdgcn_rcpf(1.f + __expf(2.f * u));
    return 0.5f * y * (1.f + t);
}
__device__ __forceinline__ void ssm_end_item(const Args& a, int l, int item, LAS unsigned char* lds, int tid, int wave, int lane) {
    const bf16_t* P = (const bf16_t*)(a.ws + OFF_P);
    const f32x4* LAMB = (const f32x4*)(a.ws + OFF_LAMB); const u32x4* BFR = (const u32x4*)(a.ws + OFF_BFR);
    const int ql = item >> 3, rb = item & 7, dir = ql >> 4, g = ql & 15, q = (l * 2 + dir) * 16 + g;
    const int fr = lane & 15, kq = lane >> 4, th = kq >> 1, j0 = 8 * (kq & 1);
    const int n = 16 * wave + fr, p = n & 63, part = n >> 6;
    float Br[8], Bi[8];
    { const int ntr = wave & 3, nti = ntr + 4, ln = fr + 16 * (kq & 1);
      const u32x4 rh = BFR[(q * 8 + ntr) * 64 + ln], rl = BFR[(q * 8 + ntr) * 64 + ln + 32], ih = BFR[(q * 8 + nti) * 64 + ln], il = BFR[(q * 8 + nti) * 64 + ln + 32];
#pragma unroll
      for (int d = 0; d < 4; ++d) { Br[2 * d] = bf_lo(rh[d]) + bf_lo(rl[d]); Br[2 * d + 1] = bf_hi(rh[d]) + bf_hi(rl[d]);
                                    Bi[2 * d] = bf_lo(ih[d]) + bf_lo(il[d]); Bi[2 * d + 1] = bf_hi(ih[d]) + bf_hi(il[d]); } }
    const f32x4 lam = LAMB[q * 64 + p];
    const float l2r = lam.x * lam.x - lam.y * lam.y, l2i = 2.f * lam.x * lam.y;
    const bool e1 = dir ? (th == 1) : (th == 0);
    float wr = e1 ? lam.x : 1.f, wi = e1 ? lam.y : 0.f;
    f32x4 acc[9];
#pragma unroll
    for (int m = 0; m < 9; ++m) acc[m] = (f32x4){0.f, 0.f, 0.f, 0.f};
    const int rbase = 144 * rb;
    unsigned go[9];
#pragma unroll
    for (int k = 0; k < 9; ++k) { const int idx = tid + 512 * k, row = idx >> 5, pc = idx & 31, r = rbase + row, b = r / 36, ci = r - 36 * b;
        const unsigned row0 = ci < 4 ? (unsigned)(TLAT + b * CTXL + 64 * ci) : (unsigned)(b * SEQ + 64 * (ci - 4));
        go[k] = (row0 + (unsigned)(pc >> 1)) * (unsigned)INW + 1536u + 16u * g + 8u * (pc & 1); }
    u32x4 st[9];
#define SE_LOADQ(kh_) do { const unsigned tb_ = (unsigned)((dir ? 16 * (kh_) : 48 - 16 * (kh_)) * INW); \
        _Pragma("unroll") for (int k = 0; k < 9; ++k) st[k] = *(const u32x4*)(P + (size_t)(go[k] + tb_)); } while (0)
    SE_LOADQ(0);
#pragma unroll 1
    for (int kh = 0; kh < 4; ++kh) {
        bf16x8 bq[8];
#pragma unroll
        for (int i = 0; i < 8; ++i) {
            float v[8];
#pragma unroll
            for (int jj = 0; jj < 8; ++jj) v[jj] = part == 0 ? (wr * Br[jj] - wi * Bi[jj]) : (wr * Bi[jj] + wi * Br[jj]);
            u32x4 o; o.x = cvt_pk_bf16(v[0], v[1]); o.y = cvt_pk_bf16(v[2], v[3]); o.z = cvt_pk_bf16(v[4], v[5]); o.w = cvt_pk_bf16(v[6], v[7]);
            bq[i] = __builtin_bit_cast(bf16x8, o);
            const float nr = wr * l2r - wi * l2i, ni = wr * l2i + wi * l2r; wr = nr; wi = ni;
        }
        __syncthreads();
#pragma unroll
        for (int k = 0; k < 9; ++k) { const int idx = tid + 512 * k; *(LAS u32x4*)(lds + (idx >> 5) * 528 + (idx & 31) * 16) = st[k]; }
        __syncthreads();
        if (kh < 3) SE_LOADQ(kh + 1);
        const LAS unsigned char* ab = lds + fr * 528 + (dir ? th : 14 + th) * 32 + j0 * 2;
        const int tstep = dir ? 64 : -64;
#pragma unroll
        for (int mt = 0; mt < 9; ++mt) {
            bf16x8 af[8];
#pragma unroll
            for (int i = 0; i < 8; ++i) af[i] = *(const LAS bf16x8*)(ab + mt * (16 * 528) + i * tstep);
#pragma unroll
            for (int i = 0; i < 8; ++i) acc[mt] = MFMA16(af[i], bq[i], acc[mt]);
            __builtin_amdgcn_sched_barrier(0);
        }
    }
#undef SE_LOADQ
    __syncthreads();
    {
        LAS float* El = (LAS float*)lds;
#pragma unroll
        for (int mt = 0; mt < 9; ++mt)
#pragma unroll
            for (int rg = 0; rg < 4; ++rg) El[(16 * mt + 4 * kq + rg) * 132 + n] = acc[mt][rg];
        __syncthreads();
        if (tid < 256) {
            const int bl = tid >> 6, pp = tid & 63, b = 4 * rb + bl;
            const f32x4 lm = LAMB[q * 64 + pp];
            f32x2* E2p = (f32x2*)(a.ws + OFF_E2) + ((size_t)((b * 2 + dir) * 36) * 16 + g) * 64 + pp;
            float hr = 0.f, hi = 0.f;
#pragma unroll 4
            for (int cd = 0; cd < 36; ++cd) {
                const int ci = dir ? (cd < 4 ? 3 - cd : 39 - cd) : cd;
                const float er = El[(bl * 36 + ci) * 132 + pp], ei = El[(bl * 36 + ci) * 132 + 64 + pp];
                E2p[(size_t)cd * 1024] = (f32x2){hr, hi};
                const float nr = lm.z * hr - lm.w * hi + er, ni = lm.z * hi + lm.w * hr + ei; hr = nr; hi = ni;
            }
        }
    }
}

__device__ __forceinline__ void carry_scan(const Args& a, int l, int wave, int lane) {
    const int gw = blockIdx.x * 8 + wave, NGW = gridDim.x * 8;
    const f32x4* LAMB = (const f32x4*)(a.ws + OFF_LAMB);
    const f32x2* E = (const f32x2*)(a.ws + OFF_E); f32x2* E2 = (f32x2*)(a.ws + OFF_E2);
    for (int task = gw; task < 1024; task += NGW) {
        const int b = task >> 5, dir = (task >> 4) & 1, g = task & 15;
        const f32x4 lam = LAMB[((l * 2 + dir) * 16 + g) * 64 + lane];
        const f32x2* Ep = E + ((size_t)((b * 2 + dir) * 36) * 16 + g) * 64 + lane;
        f32x2* Eq = E2 + ((size_t)((b * 2 + dir) * 36) * 16 + g) * 64 + lane;
        float hre = 0.f, him = 0.f;
#pragma unroll 1
        for (int c0 = 0; c0 < 36; c0 += 12) {
            f32x2 e[12];
#pragma unroll
            for (int i = 0; i < 12; ++i) e[i] = Ep[(size_t)(c0 + i) * 1024];
#pragma unroll
            for (int i = 0; i < 12; ++i) { Eq[(size_t)(c0 + i) * 1024] = (f32x2){hre, him};
                const float nre = lam.z * hre - lam.w * him + e[i].x, nim = lam.z * him + lam.w * hre + e[i].y; hre = nre; him = nim; }
        }
    }
}

template <bool PASS2>
__device__ __forceinline__ void ssm_item(const Args& a, int l, int b, int ci, LAS unsigned char* lds, int tid, int wave, int lane) {
    const bf16_t* P = (const bf16_t*)(a.ws + OFF_P);
    bf16_t* MIX = (bf16_t*)(a.ws + OFF_MIX);
    const f32x4* LAMB = (const f32x4*)(a.ws + OFF_LAMB); const bf16x8* BFR = (const bf16x8*)(a.ws + OFF_BFR); const bf16x8* CFR = (const bf16x8*)(a.ws + OFF_CFR);
    f32x2* E = (f32x2*)(a.ws + OFF_E); const f32x2* E2 = (const f32x2*)(a.ws + OFF_E2);
    const bool isctx = ci < 4; const int j = isctx ? ci : ci - 4;
    const size_t row0 = isctx ? (size_t)TLAT + (size_t)b * CTXL + 64 * j : (size_t)b * SEQ + 64 * j;
    const int cf = isctx ? j : 4 + j, cbk = isctx ? 3 - j : 35 - j;
    LAS bf16_t* U = (LAS bf16_t*)lds;
    LAS float* Dw = (LAS float*)(lds + 33792 + wave * 8448);
    LAS bf16_t* Hw = (LAS bf16_t*)(lds + 101376 + wave * 4352);
    f32x4 lamN; f32x2 hinN = {0.f, 0.f}; bf16x8 bfrN[8], cfrN[4];
#define SSM_FETCH(tk) do { const int g_ = 2 * wave + ((tk) >> 1), dir_ = (tk) & 1, q_ = (l * 2 + dir_) * 16 + g_; \
        lamN = LAMB[q_ * 64 + lane]; \
        if (PASS2) hinN = E2[((size_t)((b * 2 + dir_) * 36 + (dir_ ? cbk : cf)) * 16 + g_) * 64 + lane]; \
        _Pragma("unroll") for (int nt = 0; nt < 8; ++nt) bfrN[nt] = BFR[(q_ * 8 + nt) * 64 + lane]; \
        if (PASS2) { _Pragma("unroll") for (int ks = 0; ks < 4; ++ks) cfrN[ks] = CFR[(q_ * 4 + ks) * 64 + lane]; } } while (0)
    SSM_FETCH(0);
#pragma unroll
    for (int i = 0; i < 4; ++i) { const int piece = tid + 512 * i, t = piece >> 5, c16 = piece & 31;
        *(LAS u32x4*)(U + t * 264 + 8 * c16) = *(const u32x4*)(P + (row0 + t) * INW + 1536 + 8 * c16); }
    __syncthreads();
    const int fr = lane & 15, fq = lane >> 4;
    f32x4 acc[4];
#pragma unroll 1
    for (int tk = 0; tk < 4; ++tk) {
        const int g = 2 * wave + (tk >> 1), dir = tk & 1;
        const f32x4 lam = lamN; const float are = lam.x, aim = lam.y, naim = -lam.y;
        float hre = hinN.x, him = hinN.y;
        bf16x8 bfr[8], cfr[4];
#pragma unroll
        for (int nt = 0; nt < 8; ++nt) bfr[nt] = bfrN[nt];
#pragma unroll
        for (int ks = 0; ks < 4; ++ks) cfr[ks] = cfrN[ks];
        if (tk < 3) SSM_FETCH(tk + 1);
        if (dir == 0) {
#pragma unroll
            for (int m = 0; m < 4; ++m) acc[m] = (f32x4){0.f, 0.f, 0.f, 0.f}; }
#pragma unroll 1
        for (int sb = 0; sb < 4; ++sb) {
            const int mt = dir ? 3 - sb : sb;
            const bf16x8 uf = *(const LAS bf16x8*)(U + (16 * mt + fr) * 264 + 16 * g + 8 * (fq & 1));
#pragma unroll
            for (int nt = 0; nt < 8; ++nt) { const f32x4 d = MFMA16(uf, bfr[nt], ((f32x4){0.f, 0.f, 0.f, 0.f}));
#pragma unroll
                for (int r = 0; r < 4; ++r) Dw[(4 * fq + r) * 132 + 16 * nt + fr] = d[r]; }
            LDS_WAIT();
            float dr[16], di[16];
#pragma unroll
            for (int s = 0; s < 8; ++s) { const int t = dir ? 15 - s : s; dr[s] = Dw[t * 132 + lane]; di[s] = Dw[t * 132 + 64 + lane]; }
            LDS_WAIT();
#pragma unroll
            for (int s = 8; s < 16; ++s) { const int t = dir ? 15 - s : s; dr[s] = Dw[t * 132 + lane]; di[s] = Dw[t * 132 + 64 + lane]; }
            LDS_WAIT();
#pragma unroll
            for (int s = 0; s < 16; ++s) {
                float t1, t2, nre, nim;
                asm("v_fma_f32 %0, %1, %2, %3" : "=v"(t1) : "v"(naim), "v"(him), "v"(dr[s]));
                asm("v_fma_f32 %0, %1, %2, %3" : "=v"(t2) : "v"(aim), "v"(hre), "v"(di[s]));
                asm("v_fma_f32 %0, %1, %2, %3" : "=v"(nre) : "v"(are), "v"(hre), "v"(t1));
                asm("v_fma_f32 %0, %1, %2, %3" : "=v"(nim) : "v"(are), "v"(him), "v"(t2));
                hre = nre; him = nim;
                dr[s] = hre; di[s] = him; }
            if (PASS2) {
                unsigned pk[16];
#pragma unroll
                for (int s = 0; s < 16; ++s) pk[s] = cvt_pk_bf16(dr[s], di[s]);
#pragma unroll
                for (int s = 0; s < 16; ++s) { const int t = dir ? 15 - s : s;
                    Hw[t * 136 + lane] = (bf16_t)(pk[s] & 0xffffu); Hw[t * 136 + 64 + lane] = (bf16_t)(pk[s] >> 16);
                    if ((s & 3) == 3) LDS_WAIT(); }
            }
            LDS_WAIT();
            if (PASS2) {
                f32x4 am = acc[0];
                if (mt == 1) am = acc[1]; if (mt == 2) am = acc[2]; if (mt == 3) am = acc[3];
#pragma unroll
                for (int ks = 0; ks < 4; ++ks) { const bf16x8 hf = *(const LAS bf16x8*)(Hw + fr * 136 + 32 * ks + 8 * fq); am = MFMA16(hf, cfr[ks], am); }
                if (mt == 0) acc[0] = am; if (mt == 1) acc[1] = am; if (mt == 2) acc[2] = am; if (mt == 3) acc[3] = am;
                LDS_WAIT();
            }
        }
        if (!PASS2) E[((size_t)((b * 2 + dir) * 36 + (dir ? cbk : cf)) * 16 + g) * 64 + lane] = (f32x2){hre, him};
        if (PASS2 && dir == 1) {
            const int ch = 16 * g + fr; const float dsk = a.in[17][l * 256 + ch];
#pragma unroll
            for (int mt = 0; mt < 4; ++mt)
#pragma unroll
                for (int r = 0; r < 4; ++r) { const int t = 16 * mt + 4 * fq + r; const float u = bf2f(U[t * 264 + ch]);
                    const float y = acc[mt][r] + dsk * u; const float gl = gelu_tanh(y);
                    U[t * 264 + ch] = (bf16_t)(cvt_pk_bf16(gl, 0.f) & 0xffffu); }
        }
    }
#undef SSM_FETCH
    if (PASS2) {
        __syncthreads();
        const bf16_t* WG = (const bf16_t*)(a.ws + OFF_WGLU) + (size_t)l * 65536;
        f32x4 ga[4][2];
#pragma unroll
        for (int m = 0; m < 4; ++m)
#pragma unroll
            for (int n = 0; n < 2; ++n) ga[m][n] = (f32x4){0.f, 0.f, 0.f, 0.f};
        bf16x8 bw[8][2];
#pragma unroll
        for (int ks = 0; ks < 8; ++ks)
#pragma unroll
            for (int nt = 0; nt < 2; ++nt) bw[ks][nt] = *(const bf16x8*)(WG + (size_t)(32 * wave + 16 * nt + fr) * 256 + 32 * ks + 8 * fq);
#pragma unroll
        for (int ks = 0; ks < 8; ++ks) {
#pragma unroll
            for (int mt = 0; mt < 4; ++mt) { const bf16x8 af = *(const LAS bf16x8*)(U + (16 * mt + fr) * 264 + 32 * ks + 8 * fq);
                ga[mt][0] = MFMA16(af, bw[ks][0], ga[mt][0]); ga[mt][1] = MFMA16(af, bw[ks][1], ga[mt][1]); }
        }
#pragma unroll
        for (int nt = 0; nt < 2; ++nt) { const int n = 32 * wave + 16 * nt + fr; const float bg = a.in[19][l * 256 + n];
#pragma unroll
            for (int mt = 0; mt < 4; ++mt)
#pragma unroll
                for (int r = 0; r < 4; ++r) { const int t = 16 * mt + 4 * fq + r; const float gv = bf2f(U[t * 264 + n]);
                    const float z = ga[mt][nt][r] + bg; const float o = gv * __builtin_amdgcn_rcpf(1.f + __expf(-z));
                    MIX[(row0 + t) * 1024 + 768 + n] = (bf16_t)(cvt_pk_bf16(o, 0.f) & 0xffffu); } }
    }
    __syncthreads();
}

__device__ __forceinline__ void conv_phase(const Args& a, int l, int tid) {
    const bf16_t* P = (const bf16_t*)(a.ws + OFF_P);
    bf16_t* MIX = (bf16_t*)(a.ws + OFF_MIX);
    const float* cw = a.in[8] + l * 768;
    const int nrows = l < 3 ? TALL : TLAT;
    const int total = (nrows >> 2) * 32;
    for (int idx = blockIdx.x * 512 + tid; idx < total; idx += gridDim.x * 512) {
        const int r4 = (idx >> 5) * 4, c8 = (idx & 31) * 8;
        const int pos0 = r4 < TLAT ? (r4 & 2047) : ((r4 - TLAT) & 255);
        const int seqlen = r4 < TLAT ? SEQ : CTXL;
        const bool has_prev = pos0 != 0, has_next = (pos0 + 4) != seqlen;
        const bf16_t* pr = P + (size_t)r4 * INW + c8;
        u32x4 cc[6], cx[6], cb[4];
#pragma unroll
        for (int k = 0; k < 6; ++k) { cc[k] = (u32x4){0, 0, 0, 0}; cx[k] = cc[k]; }
        if (has_prev) { cc[0] = *(const u32x4*)(pr - INW + 1024); cx[0] = *(const u32x4*)(pr - INW + 1280); }
#pragma unroll
        for (int k = 1; k < 5; ++k) { cc[k] = *(const u32x4*)(pr + (size_t)(k - 1) * INW + 1024); cx[k] = *(const u32x4*)(pr + (size_t)(k - 1) * INW + 1280); cb[k - 1] = *(const u32x4*)(pr + (size_t)(k - 1) * INW + 768); }
        if (has_next) { cc[5] = *(const u32x4*)(pr + (size_t)4 * INW + 1024); cx[5] = *(const u32x4*)(pr + (size_t)4 * INW + 1280); }
        float w0[8], w1[8], w2[8];
#pragma unroll
        for (int d = 0; d < 8; ++d) { w0[d] = cw[c8 + d]; w1[d] = cw[256 + c8 + d]; w2[d] = cw[512 + c8 + d]; }
        float e[6][8];
#pragma unroll
        for (int k = 0; k < 6; ++k)
#pragma unroll
            for (int d = 0; d < 4; ++d) { e[k][2 * d] = bf_lo(cc[k][d]) * bf_lo(cx[k][d]); e[k][2 * d + 1] = bf_hi(cc[k][d]) * bf_hi(cx[k][d]); }
#pragma unroll
        for (int i = 0; i < 4; ++i) {
            float o[8];
#pragma unroll
            for (int d = 0; d < 4; ++d) {
                o[2 * d]     = bf_lo(cb[i][d]) * (w0[2 * d] * e[i][2 * d] + w1[2 * d] * e[i + 1][2 * d] + w2[2 * d] * e[i + 2][2 * d]);
                o[2 * d + 1] = bf_hi(cb[i][d]) * (w0[2 * d + 1] * e[i][2 * d + 1] + w1[2 * d + 1] * e[i + 1][2 * d + 1] + w2[2 * d + 1] * e[i + 2][2 * d + 1]);
            }
            u32x4 w; w.x = cvt_pk_bf16(o[0], o[1]); w.y = cvt_pk_bf16(o[2], o[3]); w.z = cvt_pk_bf16(o[4], o[5]); w.w = cvt_pk_bf16(o[6], o[7]);
            *(u32x4*)(MIX + (size_t)(r4 + i) * 1024 + 512 + c8) = w;
        }
    }
}

#define XB_TMO      128
#define XB_XCNT(j)  (256  + 64 * (j))
#define XB_XSUB(j)  (1280 + 64 * (j))
#define XB_XGEN(j)  (2304 + 64 * (j))
#define XB_TOP      3328
#define XB_TOPGEN   3392
#define XCD_BAR_WORDS 3456
#define XB_SPIN_CAP (1u << 18)
__device__ __forceinline__ unsigned xb_ld(unsigned* p)              { return __hip_atomic_load(p, __ATOMIC_RELAXED, __HIP_MEMORY_SCOPE_AGENT); }
__device__ __forceinline__ unsigned xb_add(unsigned* p, unsigned v) { return __hip_atomic_fetch_add(p, v, __ATOMIC_RELAXED, __HIP_MEMORY_SCOPE_AGENT); }
__device__ __forceinline__ unsigned xb_xcc_id() { return (unsigned)__builtin_amdgcn_s_getreg((3 << 11) | 20) & 0xFu; }
#define XB_SPIN(cond, bar) do { unsigned _sp = 0; while (cond) { __builtin_amdgcn_s_sleep(1); \
    if ((++_sp & 255u) == 0u) { if (xb_ld(&(bar)[XB_TMO])) break; if (_sp > XB_SPIN_CAP) { atomicAdd(&(bar)[XB_TMO], 1u); break; } } } } while (0)
struct XcdBarrier { unsigned* bar; unsigned x; volatile LAS unsigned* st; };
__device__ __forceinline__ XcdBarrier xcd_barrier_post(unsigned* bar, volatile LAS unsigned* st) {
    XcdBarrier b; b.bar = bar; b.x = xb_xcc_id(); b.st = st;
    if (threadIdx.x == 0) (void)xb_add(&bar[XB_XCNT(b.x)], 1u);
    return b;
}
__device__ __forceinline__ void xcd_barrier_complete(unsigned* bar, unsigned x, unsigned& nloc, unsigned& nx) {
    const unsigned G = gridDim.x * gridDim.y * gridDim.z;
    unsigned sum, cnt, mine, sp = 0u;
    for (;;) {
        sum = 0u; cnt = 0u; mine = 0u;
#pragma unroll
        for (unsigned j = 0; j < 16; ++j) { const unsigned c = xb_ld(&bar[XB_XCNT(j)]); sum += c; cnt += (c > 0u) ? 1u : 0u; mine = (j == x) ? c : mine; }
        if (sum == G) break;
        __builtin_amdgcn_s_sleep(1);
        if ((++sp & 255u) == 0u) { if (xb_ld(&bar[XB_TMO])) break; if (sp > XB_SPIN_CAP) { atomicAdd(&bar[XB_TMO], 1u); break; } }
    }
    nloc = mine > 0u ? mine : 1u; nx = cnt > 0u ? cnt : 1u;
}
__device__ __forceinline__ void xcd_barrier(const XcdBarrier& b) {
    asm volatile("s_waitcnt vmcnt(0)" ::: "memory");
    __syncthreads();
    if (threadIdx.x == 0) {
        unsigned* bar = b.bar;
        __builtin_amdgcn_s_waitcnt(0);
        unsigned nloc = b.st[0], nx = b.st[1];
        if (nloc == 0u) { xcd_barrier_complete(bar, b.x, nloc, nx); b.st[0] = nloc; b.st[1] = nx; }
        const unsigned old = xb_add(&bar[XB_XSUB(b.x)], 1u);
        const unsigned gen = old / nloc;
        if (old + 1u == (gen + 1u) * nloc) {
            __builtin_amdgcn_fence(__ATOMIC_RELEASE, "agent");
            asm volatile("s_waitcnt vmcnt(0)" ::: "memory");
            const unsigned og = xb_add(&bar[XB_TOP], 1u);
            const unsigned tg = og / nx;
            if (og + 1u == (tg + 1u) * nx) xb_add(&bar[XB_TOPGEN], 1u);
            else XB_SPIN(xb_ld(&bar[XB_TOPGEN]) == tg, bar);
            __builtin_amdgcn_fence(__ATOMIC_ACQUIRE, "agent");
            xb_add(&bar[XB_XGEN(b.x)], 1u);
            asm volatile("s_waitcnt vmcnt(0)" ::: "memory");
        } else {
            XB_SPIN(xb_ld(&bar[XB_XGEN(b.x)]) == gen, bar);
            __builtin_amdgcn_fence(__ATOMIC_ACQUIRE, "agent");
            asm volatile("s_waitcnt vmcnt(0)" ::: "memory");
        }
    }
    __syncthreads();
}

__global__ void __launch_bounds__(512) mk_fwd(Args a) {
    extern __shared__ __attribute__((aligned(16))) unsigned char smem[];
    LAS unsigned char* lds = (LAS unsigned char*)smem;
    cg::grid_group grid = cg::this_grid();
    const int G = gridDim.x;
#define FRESH() const int tid = fresh_tid(); const int lane = tid & 63; const int wave = __builtin_amdgcn_readfirstlane(tid >> 6); (void)tid; (void)lane; (void)wave
    const int lo = a.ph_lo, hi = a.ph_hi;
#define IN(k) (lo <= (k) && (k) < hi)
    volatile LAS unsigned* xb_st = (volatile LAS unsigned*)(lds + LDS_BYTES - 16);
    if (threadIdx.x < 4) xb_st[threadIdx.x] = 0u;
    __syncthreads();
    const XcdBarrier xbar = xcd_barrier_post((unsigned*)(a.ws + OFF_BAR), xb_st);
#define SYNC(k) do { if ((k) + 1 < hi) { if (hi < 0) grid.sync(); else xcd_barrier(xbar); } } while (0)
    if (IN(0)) { { FRESH(); phase_prep(a, lds, tid, wave, lane); } SYNC(0); }
    if (IN(1)) { { FRESH(); row_pass<0>(a, 0, wave, lane); } SYNC(1); }
#pragma unroll 1
    for (int l = 0; l < DEPTH; ++l) {
        const int ph = 2 + 8 * l;
        const int Mrows = l < 3 ? TALL : TLAT;
        if (IN(ph + 0)) {
            pg8::Gemm g{(const bf16_t*)(a.ws + OFF_A), (const bf16_t*)(a.ws + OFF_WIN) + (size_t)l * INW * 1024, 1024};
            pg8::Order S; S.nM = Mrows / 256; S.nN = 7; S.nwg = S.nM * 7; S.G = G; S.c = blockIdx.x; S.extra = l < 3 ? 0 : 64; S.split = 0;
            pg8::EpiP E{(bf16_t*)(a.ws + OFF_P), (const float*)(a.ws + OFF_ROPE), (const float*)(a.ws + OFF_ROPE) + 1024};
            for (int rep = 0; rep < REP_GEMM; ++rep) pg8::gemm_phase<pg8::EpiP>(lds, g, S, E);
            SYNC(ph + 0);
        }
        if (IN(ph + 1)) {
            FRESH();
            for (int rep = 0; rep < REP_MIX; ++rep) {
                for (int it = blockIdx.x; it < 256; it += G) ssm_end_item(a, l, it, lds, tid, wave, lane);
                conv_phase(a, l, tid);
            }
            SYNC(ph + 1);
        }
        if (IN(ph + 2)) {
            FRESH();
            const int nit = l < 3 ? 1152 : 1024, nattn = l < 3 ? 2304 : 2048;
            for (int it = blockIdx.x; it < nit; it += G) {
                int b, ci; if (l < 3) { b = it / 36; ci = it % 36; } else { b = it >> 5; ci = 4 + (it & 31); }
                ssm_item<true>(a, l, b, ci, lds, tid, wave, lane);
            }
            {
                for (int it = blockIdx.x; it < 2048; it += G) attn_item(a, l, it, lds, tid, wave, lane);
                if (nattn > 2048 && G == 256) { if (blockIdx.x >= 128) { const int e = 2048 + 2 * ((int)blockIdx.x - 128); attn_item(a, l, e, lds, tid, wave, lane); attn_item(a, l, e + 1, lds, tid, wave, lane); } }
                else for (int it = 2048 + blockIdx.x; it < nattn; it += G) attn_item(a, l, it, lds, tid, wave, lane);
            }
            SYNC(ph + 2);
        }
        if (IN(ph + 3)) {
            pg8::Gemm g{(const bf16_t*)(a.ws + OFF_MIX), (const bf16_t*)(a.ws + OFF_WOUT) + (size_t)l * 1024 * 1024, 1024};
            pg8::Order S; S.nM = 256; S.nN = 4; S.nwg = 1024; S.G = G; S.c = blockIdx.x; S.extra = l < 3 ? 256 : 0; S.split = 1;
            pg8::EpiBf<0> E{(bf16_t*)(a.ws + OFF_MB), 1024, (bf16_t*)(a.ws + OFF_E)};
            for (int rep = 0; rep < REP_GEMM; ++rep) pg8::gemm_phase<pg8::EpiBf<0>>(lds, g, S, E);
            SYNC(ph + 3);
        }
        if (IN(ph + 4)) { { FRESH(); row_pass<1>(a, l, wave, lane); } SYNC(ph + 4); }
        if (IN(ph + 5)) {
            pg8::Gemm g{(const bf16_t*)(a.ws + OFF_A), (const bf16_t*)(a.ws + OFF_W1) + (size_t)l * DFF * 1024, 1024};
            pg8::Order S; S.nM = Mrows / 256; S.nN = 16; S.nwg = S.nM * 16; S.G = G; S.c = blockIdx.x; S.extra = 0; S.split = 0;
            pg8::EpiBf<1> E{(bf16_t*)(a.ws + OFF_Z), DFF, nullptr};
            for (int rep = 0; rep < REP_GEMM; ++rep) pg8::gemm_phase<pg8::EpiBf<1>>(lds, g, S, E);
            SYNC(ph + 5);
        }
        if (IN(ph + 6)) {
            pg8::Gemm g{(const bf16_t*)(a.ws + OFF_Z), (const bf16_t*)(a.ws + OFF_W2) + (size_t)l * 1024 * DFF, DFF};
            pg8::Order S; S.nM = 256; S.nN = 4; S.nwg = 1024; S.G = G; S.c = blockIdx.x; S.extra = l < 3 ? 256 : 0; S.split = 1;
            pg8::EpiBf<0> E{(bf16_t*)(a.ws + OFF_MB), 1024, (bf16_t*)(a.ws + OFF_E)};
            for (int rep = 0; rep < REP_GEMM; ++rep) pg8::gemm_phase<pg8::EpiBf<0>>(lds, g, S, E);
            SYNC(ph + 6);
        }
        if (IN(ph + 7)) { { FRESH(); row_pass<2>(a, l, wave, lane); } SYNC(ph + 7); }
    }
#undef IN
#undef SYNC
#undef FRESH
}

extern "C" void kernel_launch(void* const* d_in, const int* in_sizes, int n_in, void* d_out, int out_size, void* d_ws, size_t ws_size, hipStream_t stream) {
    static int grid = 0;
    if (grid == 0) {
        if (n_in != 23 || out_size != TLAT * DM || ws_size < WS_END) { fprintf(stderr, "kernel_launch: unexpected shapes (n_in %d out %d ws %zu need %zu)\n", n_in, out_size, ws_size, (size_t)WS_END); grid = -1; return; }
        int dev = 0, cus = 0, per_cu = 0;
        (void)hipGetDevice(&dev);
        (void)hipDeviceGetAttribute(&cus, hipDeviceAttributeMultiprocessorCount, dev);
        if (hipFuncSetAttribute((const void*)mk_fwd, hipFuncAttributeMaxDynamicSharedMemorySize, LDS_BYTES) != hipSuccess) { fprintf(stderr, "kernel_launch: hipFuncSetAttribute failed\n"); grid = -1; return; }
        (void)hipOccupancyMaxActiveBlocksPerMultiprocessor(&per_cu, (const void*)mk_fwd, 512, LDS_BYTES);
        if (per_cu < 1) { fprintf(stderr, "kernel_launch: occupancy query says %d blocks per CU\n", per_cu); per_cu = 1; }
        (void)hipGetLastError();
        grid = cus;
    }
    if (grid < 0) return;
    Args a{};
    for (int i = 0; i < 23; ++i) a.in[i] = (const float*)d_in[i];
    a.out = (float*)d_out; a.ws = (unsigned char*)d_ws; a.ph_lo = 0; a.ph_hi = 34;
    if (hipMemsetAsync((unsigned char*)d_ws + OFF_BAR, 0, XCD_BAR_WORDS * sizeof(unsigned), stream) != hipSuccess) { fprintf(stderr, "kernel_launch: hipMemsetAsync of the barrier words failed\n"); return; }
    void* args[] = {&a};
    hipError_t e = hipLaunchCooperativeKernel((const void*)mk_fwd, dim3(grid), dim3(512), args, LDS_BYTES, stream);
    if (e != hipSuccess) fprintf(stderr, "cooperative launch failed: %s (grid %d)\n", hipGetErrorString(e), grid);
}
```
